# Optimizing an MI355X kernel written in HIP

```python
import math
import jax
import jax.numpy as jnp
from jax import lax
import numpy as np

D_MODEL = 1024
BATCH = 32
SEQ = 256
DEPTH = 4
DEC_BATCH = 8
DEC_SEQ = 4096
PAST_LEN = 512

GRID_W = 64
HEAD_DIM = 64
BLOCK = 128
N_AB = (DEPTH + 1) // 2
N_C = DEPTH // 2
A_HEADS = 8
A_KV_HEADS = 2
A_GROUP = A_HEADS // A_KV_HEADS
WINDOW = 128
A_COLS = (A_HEADS + 2 * A_KV_HEADS) * HEAD_DIM
B_HEADS = 8
B_WIDTH = B_HEADS * HEAD_DIM
DECAY_LORA = 64
AAA_LORA = 64
GATE_LORA = 128
B_COLS = 3 * B_WIDTH + 2 * DECAY_LORA + 2 * AAA_LORA + GATE_LORA
AB_COLS = A_COLS + B_COLS
C_HEADS = 8
C_VDIM = 2 * HEAD_DIM
C_COLS = 3 * C_HEADS * C_VDIM
D_FF = 2816
N_MOD = 9
ROPE_THETA = 10000.0
NORM_EPS = 1e-6
GN_EPS = 64e-5
SUBLN_EPS = 1e-5

kernel_name = "hybrid_diffusion_trunk_step"


def _split(x, sizes):
    idx = np.cumsum(sizes)[:-1].tolist()
    return jnp.split(x, idx, axis=-1)


def _rmsnorm(x, g):
    xf = x.astype(jnp.float32)
    y = xf * lax.rsqrt(jnp.mean(xf * xf, axis=-1, keepdims=True) + NORM_EPS)
    return (y * g.astype(jnp.float32)).astype(x.dtype)


def _swiglu(h, w1, w3, w2):
    return (jax.nn.silu(h @ w1) * (h @ w3)) @ w2


def _axial_rope(n_tok):
    n_rows = n_tok // GRID_W
    row = jnp.repeat(jnp.arange(n_rows, dtype=jnp.float32), GRID_W)
    col = jnp.tile(jnp.arange(GRID_W, dtype=jnp.float32), n_rows)
    n_freq = HEAD_DIM // 4
    inv = jnp.power(ROPE_THETA, -jnp.arange(n_freq, dtype=jnp.float32) / n_freq)
    ang_r = (row[:, None] * inv)[:, None, :]
    ang_c = (col[:, None] * inv)[:, None, :]
    return (jnp.cos(ang_r), jnp.sin(ang_r), jnp.cos(ang_c), jnp.sin(ang_c))


def _rotate(x, cos, sin):
    x1, x2 = jnp.split(x, 2, axis=-1)
    return jnp.concatenate([x1 * cos - x2 * sin, x2 * cos + x1 * sin], axis=-1)


def _apply_axial_rope(x, rope):
    cos_r, sin_r, cos_c, sin_c = rope
    x_row, x_col = jnp.split(x.astype(jnp.float32), 2, axis=-1)
    return jnp.concatenate([_rotate(x_row, cos_r, sin_r), _rotate(x_col, cos_c, sin_c)], axis=-1).astype(x.dtype)


def _rope_pairs(x, rope):
    b, t, h, _ = x.shape
    return _apply_axial_rope(x.reshape(b, t, 2 * h, HEAD_DIM), rope).reshape(b, t, h, 2 * HEAD_DIM)


def _gqa_blocks(q, k_ctx, v_ctx, sink, k_lat=None, v_lat=None):
    bn, t = q.shape[0], q.shape[1]
    n_ctx = k_ctx.shape[1]
    nb = t // BLOCK
    scale = HEAD_DIM ** -0.5
    qb = q.reshape(bn, nb, BLOCK, A_KV_HEADS, A_GROUP, HEAD_DIM).swapaxes(0, 1)
    sink_s = jnp.broadcast_to(sink.astype(jnp.float32).reshape(1, A_KV_HEADS, A_GROUP, 1, 1),
                              (bn, A_KV_HEADS, A_GROUP, BLOCK, 1))
    windowed = k_lat is not None
    if windowed:
        pad = ((0, 0), (BLOCK, BLOCK), (0, 0), (0, 0))
        kp, vp = jnp.pad(k_lat, pad), jnp.pad(v_lat, pad)
        rel = jnp.arange(3 * BLOCK)[None, :] - BLOCK - jnp.arange(BLOCK)[:, None]
        band = jnp.abs(rel) <= WINDOW

    def one_block(args):
        qi, i = args
        s_ctx = jnp.einsum("bqkgd,blkd->bkgql", qi, k_ctx).astype(jnp.float32) * scale
        parts = [s_ctx, sink_s]
        if windowed:
            start = i * BLOCK
            kw = lax.dynamic_slice_in_dim(kp, start, 3 * BLOCK, axis=1)
            vw = lax.dynamic_slice_in_dim(vp, start, 3 * BLOCK, axis=1)
            kpos = start - BLOCK + jnp.arange(3 * BLOCK)
            valid = band & ((kpos >= 0) & (kpos < t))[None, :]
            s_win = jnp.einsum("bqkgd,blkd->bkgql", qi, kw).astype(jnp.float32) * scale
            parts = [jnp.where(valid, s_win, -jnp.inf)] + parts
        p = jax.nn.softmax(jnp.concatenate(parts, axis=-1), axis=-1)
        if windowed:
            p_win = p[..., :3 * BLOCK].astype(vw.dtype)
            p_ctx = p[..., 3 * BLOCK:3 * BLOCK + n_ctx].astype(v_ctx.dtype)
            return (jnp.einsum("bkgql,blkd->bqkgd", p_win, vw)
                    + jnp.einsum("bkgql,blkd->bqkgd", p_ctx, v_ctx))
        return jnp.einsum("bkgql,blkd->bqkgd", p[..., :n_ctx].astype(v_ctx.dtype), v_ctx)

    out = lax.map(one_block, (qb, jnp.arange(nb)))
    return out.swapaxes(0, 1).reshape(bn, t, A_HEADS * HEAD_DIM)


def _token_shift(p, mu_prev, mu_next):
    prev = jnp.pad(p, ((0, 0), (1, 0), (0, 0)))[:, :-1]
    nxt = jnp.pad(p, ((0, 0), (0, 1), (0, 0)))[:, 1:]
    return p + mu_prev * (prev - p) + mu_next * (nxt - p)


def _wkv_scan(r, w, k, v, kk, a, s0, reverse):
    xs = tuple(z.astype(jnp.float32).transpose(1, 0, 2, 3) for z in (r, w, k, v, kk, a))

    def step(s, inp):
        r_t, w_t, k_t, v_t, kk_t, a_t = inp
        sa = jnp.einsum("bhij,bhj->bhi", s, kk_t)
        s = (s * w_t[:, :, None, :] - sa[..., None] * (kk_t * a_t)[:, :, None, :]
             + v_t[..., None] * k_t[:, :, None, :])
        return s, jnp.einsum("bhij,bhj->bhi", s, r_t)

    s_fin, ys = lax.scan(step, s0.astype(jnp.float32), xs, reverse=reverse)
    return ys.transpose(1, 0, 2, 3), s_fin


def _rwkv_mixer(pb, s0, j, W):
    bn, t, _ = pb.shape
    r, k, v, wf, wb, af, ab, gd = _split(
        pb, (B_WIDTH, B_WIDTH, B_WIDTH, DECAY_LORA, DECAY_LORA, AAA_LORA, AAA_LORA, GATE_LORA))
    hs = lambda z: z.astype(jnp.float32).reshape(bn, t, B_HEADS, HEAD_DIM)
    kk = hs(k * W["b_k_k"][j])
    kk = kk / jnp.maximum(jnp.sqrt(jnp.sum(kk * kk, axis=-1, keepdims=True)), 1e-12)
    rh, vh = hs(r), hs(v)
    ys, bonus, finals = [], [], []
    for d, (w_dn, a_dn) in enumerate(((wf, af), (wb, ab))):
        w_log = -jax.nn.softplus(-(W["b_w0"][j, d] + jnp.tanh(w_dn) @ W["b_w2"][j, d])) - 0.5
        decay = jnp.exp(-jnp.exp(w_log.astype(jnp.float32)))
        a = jax.nn.sigmoid(W["b_a0"][j, d] + a_dn @ W["b_a2"][j, d])
        k_d = hs(k * (1 + (a - 1) * W["b_k_a"][j]))
        y_d, s_d = _wkv_scan(rh, hs(decay), k_d, vh, kk, hs(a), s0[:, d], reverse=(d == 1))
        ys.append(y_d)
        bonus.append(jnp.sum(rh * k_d * W["b_r_k"][j].astype(jnp.float32), axis=-1, keepdims=True) * vh)
        finals.append(s_d)
    y = ys[0] + ys[1]
    mu = jnp.mean(y, axis=-1, keepdims=True)
    var = jnp.mean(jnp.square(y - mu), axis=-1, keepdims=True)
    yn = ((y - mu) * lax.rsqrt(var + GN_EPS)).reshape(bn, t, B_WIDTH) * W["b_gn_w"][j] + W["b_gn_b"][j]
    yn = yn + (bonus[0] + bonus[1]).reshape(bn, t, B_WIDTH)
    g = jax.nn.sigmoid(gd) @ W["b_g2"][j]
    return (yn * g).astype(pb.dtype), jnp.stack(finals, axis=1)


def _mixer_ab(h, j, W, rope, cache):
    bn, t, _ = h.shape
    p = h @ W["w_in_ab"][j]
    qa, ka, va = _split(p[..., :A_COLS], (A_HEADS * HEAD_DIM, A_KV_HEADS * HEAD_DIM, A_KV_HEADS * HEAD_DIM))
    qa = qa.reshape(bn, t, A_HEADS, HEAD_DIM)
    ka = ka.reshape(bn, t, A_KV_HEADS, HEAD_DIM)
    va = va.reshape(bn, t, A_KV_HEADS, HEAD_DIM)
    pb = _token_shift(p[..., A_COLS:], W["b_mu_prev"][j], W["b_mu_next"][j])
    sink = W["a_sink"][j]
    if cache is None:
        oa = _gqa_blocks(qa, ka, va, sink)
        s0 = jnp.zeros((bn, 2, B_HEADS, HEAD_DIM, HEAD_DIM), jnp.float32)
    else:
        k_ctx, v_ctx, s0 = cache
        oa = _gqa_blocks(_apply_axial_rope(qa, rope), k_ctx, v_ctx, sink,
                         _apply_axial_rope(ka, rope), va)
    ob, s_fin = _rwkv_mixer(pb, s0, j, W)
    out = jnp.concatenate([oa, ob], axis=-1) @ W["w_out_ab"][j]
    return out, (ka, va, s_fin)


def _diff_attn(q, k, v, lam):
    bn, t = q.shape[0], q.shape[1]
    nb = t // BLOCK
    scale = HEAD_DIM ** -0.5
    qb = q.reshape(bn, nb, BLOCK, C_HEADS, 2, HEAD_DIM).swapaxes(0, 1)
    k2 = k.reshape(bn, k.shape[1], C_HEADS, 2, HEAD_DIM)

    def one_block(qi):
        s = jnp.einsum("bqhmd,bnhmd->bhmqn", qi, k2).astype(jnp.float32) * scale
        p = jax.nn.softmax(s, axis=-1)
        amap = p[:, :, 0] - lam * p[:, :, 1]
        return jnp.einsum("bhqn,bnhe->bqhe", amap.astype(v.dtype), v)

    o = lax.map(one_block, qb)
    return o.swapaxes(0, 1).reshape(bn, t, C_HEADS, C_VDIM)


def _mixer_c(h, j, l, W, rope, cache):
    bn, t, _ = h.shape
    q, k, v = jnp.split(h @ W["w_in_c"][j], 3, axis=-1)
    shp = (bn, t, C_HEADS, 2 * HEAD_DIM)
    q, k, v = q.reshape(shp), k.reshape(shp), v.reshape(shp)
    lam_init = 0.8 - 0.6 * math.exp(-0.3 * l)
    lam = (jnp.exp(jnp.sum(W["c_lq1"][j] * W["c_lk1"][j]).astype(jnp.float32))
           - jnp.exp(jnp.sum(W["c_lq2"][j] * W["c_lk2"][j]).astype(jnp.float32)) + lam_init)
    if cache is None:
        o = _diff_attn(q, k, v, lam)
    else:
        k_ctx, v_ctx = cache
        keys = jnp.concatenate([k_ctx, _rope_pairs(k, rope)], axis=1)
        vals = jnp.concatenate([v_ctx, v], axis=1)
        o = _diff_attn(_rope_pairs(q, rope), keys, vals, lam)
    of = o.astype(jnp.float32)
    of = of * lax.rsqrt(jnp.mean(of * of, axis=-1, keepdims=True) + SUBLN_EPS) * W["c_subln"][j] * (1.0 - lam_init)
    out = of.astype(h.dtype).reshape(bn, t, C_HEADS * C_VDIM) @ W["w_out_c"][j]
    return out, (k, v)


def _forward(x, cond, caches, W, latent):
    t = x.shape[1]
    rope = _axial_rope(t) if latent else None
    ak, av, bs, ck, cv = [], [], [], [], []
    for l in range(DEPTH):
        mod = (jax.nn.silu(cond) @ W["mod_w"][l] + W["mod_b"][l]).reshape(-1, 1, N_MOD * D_MODEL)
        sh1, sc1, g1, sh2, sc2, g2, sh3, sc3, g3 = jnp.split(mod, N_MOD, axis=-1)
        h = _rmsnorm(x, W["norms"][l, 0]) * (1 + sc1) + sh1
        x = x + 0.5 * g1 * _swiglu(h, W["ffn_w1"][l, 0], W["ffn_w3"][l, 0], W["ffn_w2"][l, 0])
        h = _rmsnorm(x, W["norms"][l, 1]) * (1 + sc2) + sh2
        j = l // 2
        if l % 2 == 0:
            cache = (caches["a_k"][:, j], caches["a_v"][:, j], caches["b_s"][:, j]) if latent else None
            m, st = _mixer_ab(h, j, W, rope, cache)
            if not latent:
                ak.append(st[0]); av.append(st[1]); bs.append(st[2])
        else:
            cache = (caches["c_k"][:, j], caches["c_v"][:, j]) if latent else None
            m, st = _mixer_c(h, j, l, W, rope, cache)
            if not latent:
                ck.append(st[0]); cv.append(st[1])
        x = x + g2 * m.astype(x.dtype)
        h = _rmsnorm(x, W["norms"][l, 2]) * (1 + sc3) + sh3
        x = x + 0.5 * g3 * _swiglu(h, W["ffn_w1"][l, 1], W["ffn_w3"][l, 1], W["ffn_w2"][l, 1])
    return _rmsnorm(x, W["final_norm"]), (ak, av, bs, ck, cv)


def setup_inputs(seed: int = 0) -> dict:
    key = jax.random.key(seed)
    ks = iter(jax.random.split(key, 48))
    nrm = lambda shape, s=1.0: s * jax.random.normal(next(ks), shape, jnp.float32)
    uni = lambda shape, lo, hi: jax.random.uniform(next(ks), shape, jnp.float32, lo, hi)
    D = D_MODEL
    return {
        "x_prompt": nrm((BATCH, SEQ, D)),
        "x_sample": nrm((DEC_BATCH, DEC_SEQ, D)),
        "c": nrm((DEC_BATCH, D)),
        "c_ctx": nrm((D,)),
        "cache_a_k": nrm((DEC_BATCH, N_AB, PAST_LEN, A_KV_HEADS, HEAD_DIM)),
        "cache_a_v": nrm((DEC_BATCH, N_AB, PAST_LEN, A_KV_HEADS, HEAD_DIM)),
        "state_b_wkv": nrm((DEC_BATCH, N_AB, 2, B_HEADS, HEAD_DIM, HEAD_DIM), 0.5),
        "cache_c_k": nrm((DEC_BATCH, N_C, PAST_LEN, C_HEADS, 2 * HEAD_DIM)),
        "cache_c_v": nrm((DEC_BATCH, N_C, PAST_LEN, C_HEADS, C_VDIM)),
        "norms": 1.0 + nrm((DEPTH, 3, D), 0.02),
        "mod_w": nrm((DEPTH, D, N_MOD * D), 0.02),
        "mod_b": nrm((DEPTH, N_MOD * D), 0.02),
        "ffn_w1": nrm((DEPTH, 2, D, D_FF), D ** -0.5),
        "ffn_w3": nrm((DEPTH, 2, D, D_FF), D ** -0.5),
        "ffn_w2": nrm((DEPTH, 2, D_FF, D), D_FF ** -0.5),
        "w_in_ab": nrm((N_AB, D, AB_COLS), D ** -0.5),
        "w_out_ab": nrm((N_AB, A_HEADS * HEAD_DIM + B_WIDTH, D), (A_HEADS * HEAD_DIM + B_WIDTH) ** -0.5),
        "a_sink": nrm((N_AB, A_HEADS), 0.5),
        "b_mu_prev": uni((N_AB, B_COLS), 0.0, 0.5),
        "b_mu_next": uni((N_AB, B_COLS), 0.0, 0.5),
        "b_w0": uni((N_AB, 2, B_WIDTH), -5.0, 0.0),
        "b_w2": nrm((N_AB, 2, DECAY_LORA, B_WIDTH), 0.1),
        "b_a0": nrm((N_AB, 2, B_WIDTH), 0.5),
        "b_a2": nrm((N_AB, 2, AAA_LORA, B_WIDTH), 0.1),
        "b_k_k": 0.85 + nrm((N_AB, B_WIDTH), 0.05),
        "b_k_a": 1.0 + nrm((N_AB, B_WIDTH), 0.05),
        "b_r_k": nrm((N_AB, B_HEADS, HEAD_DIM), 0.1),
        "b_g2": nrm((N_AB, GATE_LORA, B_WIDTH), GATE_LORA ** -0.5),
        "b_gn_w": 1.0 + nrm((N_AB, B_WIDTH), 0.02),
        "b_gn_b": nrm((N_AB, B_WIDTH), 0.02),
        "w_in_c": nrm((N_C, D, C_COLS), D ** -0.5),
        "w_out_c": nrm((N_C, C_HEADS * C_VDIM, D), (C_HEADS * C_VDIM) ** -0.5),
        "c_lq1": nrm((N_C, HEAD_DIM), 0.1),
        "c_lk1": nrm((N_C, HEAD_DIM), 0.1),
        "c_lq2": nrm((N_C, HEAD_DIM), 0.1),
        "c_lk2": nrm((N_C, HEAD_DIM), 0.1),
        "c_subln": 1.0 + nrm((N_C, C_VDIM), 0.02),
        "final_norm": 1.0 + nrm((D,), 0.02),
    }


def reference(x_prompt, x_sample, c, c_ctx, cache_a_k, cache_a_v, state_b_wkv, cache_c_k, cache_c_v,
              norms, mod_w, mod_b, ffn_w1, ffn_w3, ffn_w2,
              w_in_ab, w_out_ab, a_sink, b_mu_prev, b_mu_next, b_w0, b_w2, b_a0, b_a2,
              b_k_k, b_k_a, b_r_k, b_g2, b_gn_w, b_gn_b,
              w_in_c, w_out_c, c_lq1, c_lk1, c_lq2, c_lk2, c_subln, final_norm):
    W = dict(norms=norms, mod_w=mod_w, mod_b=mod_b, ffn_w1=ffn_w1, ffn_w3=ffn_w3, ffn_w2=ffn_w2,
             w_in_ab=w_in_ab, w_out_ab=w_out_ab, a_sink=a_sink, b_mu_prev=b_mu_prev, b_mu_next=b_mu_next,
             b_w0=b_w0, b_w2=b_w2, b_a0=b_a0, b_a2=b_a2, b_k_k=b_k_k, b_k_a=b_k_a, b_r_k=b_r_k,
             b_g2=b_g2, b_gn_w=b_gn_w, b_gn_b=b_gn_b, w_in_c=w_in_c, w_out_c=w_out_c,
             c_lq1=c_lq1, c_lk1=c_lk1, c_lq2=c_lq2, c_lk2=c_lk2, c_subln=c_subln, final_norm=final_norm)
    y_prompt, (ak, av, bs, ck, cv) = _forward(x_prompt, c_ctx, None, W, latent=False)
    caches = dict(a_k=cache_a_k, a_v=cache_a_v, b_s=state_b_wkv, c_k=cache_c_k, c_v=cache_c_v)
    y_sample, _ = _forward(x_sample, c, caches, W, latent=True)
    new_a_k = jnp.stack(ak, axis=1)
    new_a_v = jnp.stack(av, axis=1)
    new_b_wkv = jnp.stack(bs, axis=1)
    new_c_k = jnp.stack(ck, axis=1)
    new_c_v = jnp.stack(cv, axis=1)
    return (y_prompt, y_sample, new_a_k, new_a_v, new_b_wkv, new_c_k, new_c_v)
```

```cpp
#include <hip/hip_runtime.h>
#include <hip/hip_cooperative_groups.h>
#include <cstdio>
#include <cstdint>
namespace cg = cooperative_groups;

constexpr int DM = 1024, MTOK = 40960, MPR = 8192, TP = 256, TL = 4096, NSEQP = 32, NSEQL = 8;
constexpr int DFF = 2816, ABC = 2688, ABCP = 2816, CC = 3072, NMOD = 9, MODW = 9216;
constexpr int PLD_AB = 2816, PLD_C = 2048;
namespace pg8 {
#define PG8_LAS __attribute__((address_space(3)))
typedef unsigned short bf16_t;
typedef short bf16x8 __attribute__((ext_vector_type(8)));
typedef float f32x4 __attribute__((ext_vector_type(4)));
typedef unsigned u32x4 __attribute__((ext_vector_type(4)));
constexpr int BM = 256, BK = 64, HALF = 128, HTB = HALF * BK * 2  , STAGE_BYTES = 8 * HTB, NXCD = 8, WGM = 4;

__host__ __device__ __forceinline__ int lds_byte(int r, int c) { const int st = (r >> 4) * 2 + (c >> 5), rr = r & 15, cc = c & 31, ob = rr * 64 + cc * 2; return st * 1024 + (ob ^ (((ob >> 9) & 1) << 5)); }
__host__ __device__ __forceinline__ void stage_rc(int b, int& R, int& C) { const int st = b / 1024, sb = b % 1024, swz = sb ^ (((sb >> 9) & 1) << 5); R = (st >> 1) * 16 + swz / 64; C = (st & 1) * 32 + (swz % 64) / 2; }
__host__ __device__ __forceinline__ int perm32(int rho) { const int n = rho >> 4, i = rho & 15; return 8 * (i >> 2) + 4 * n + (i & 3); }

struct Unit { int pm, pn, kq; };
struct Gemm { const bf16_t* A; const bf16_t* Bt; int M, N, K, ld; };

struct StaticOrder {
    int nM, nN, nwg, G, c;
    __host__ __device__ void init(int M, int N, int G_, int c_) { nM = M / BM; nN = N / BM; nwg = nM * nN; G = G_; c = c_; }
    __host__ __device__ bool next(int i, Unit& u) const {
        const long L = (long)i * G + c; if (L >= nwg) return false;
        int wgid = (int)L; { const int q = nwg / NXCD, r = nwg % NXCD, xcd = wgid % NXCD, off = wgid / NXCD; wgid = (xcd < r ? xcd * (q + 1) : r * (q + 1) + (xcd - r) * q) + off; }
        const int nig = WGM * nN, gid = wgid / nig, fm = gid * WGM, gsz = (nM - fm) < WGM ? (nM - fm) : WGM;
        u.pm = fm + ((wgid % nig) % gsz); u.pn = (wgid % nig) / gsz; u.kq = 0; return true;
    }
    __device__ __forceinline__ void a_ready(const Unit&) const {}
    __device__ __forceinline__ void done(const Unit&) const {}
};
struct SplitOrder {
    int nM, nN, nwg, G, c;
    __host__ __device__ void init(int M, int N, int G_, int c_) { nM = M / BM; nN = N / BM; nwg = 2 * nM * nN; G = G_; c = c_; }
    __host__ __device__ bool next(int i, Unit& u) const {
        const long L = (long)i * G + c; if (L >= nwg) return false;
        int wgid = (int)L; { const int q = nwg / NXCD, r = nwg % NXCD, xcd = wgid % NXCD, off = wgid / NXCD; wgid = (xcd < r ? xcd * (q + 1) : r * (q + 1) + (xcd - r) * q) + off; }
        u.kq = wgid & 1; wgid >>= 1;
        const int nig = WGM * nN, gid = wgid / nig, fm = gid * WGM, gsz = (nM - fm) < WGM ? (nM - fm) : WGM;
        u.pm = fm + ((wgid % nig) % gsz); u.pn = (wgid % nig) / gsz; return true;
    }
    __device__ __forceinline__ void a_ready(const Unit&) const {}
    __device__ __forceinline__ void done(const Unit&) const {}
};


__device__ __forceinline__ unsigned cvt_pk_bf16(float lo, float hi) { unsigned r; asm volatile("v_cvt_pk_bf16_f32 %0, %1, %2" : "=v"(r) : "v"(lo), "v"(hi)); return r; }
typedef float f32x2 __attribute__((ext_vector_type(2)));
typedef float f32x2 __attribute__((ext_vector_type(2)));
__device__ __forceinline__ float silu_f(float x) { return x * __builtin_amdgcn_rcpf(1.0f + __builtin_amdgcn_exp2f(-1.4426950408889634f * x)); }
struct EpiSwiGLU {
    static constexpr bool PERM = true, AFTER_DRAIN = false;
    bf16_t* G;
    __device__ __forceinline__ void operator()(const f32x4 (&acc)[2][2][4][2], const Unit& u, int wr, int wc, int fr, int fq) const {
        const int row0 = u.pm * BM + wr * 64 + fr; const int col0 = u.pn * 128 + wc * 32 + 8 * fq;
#pragma unroll
        for (int ai = 0; ai < 2; ++ai)
#pragma unroll
            for (int m = 0; m < 4; ++m) {
                bf16_t* rowp = G + (size_t)(row0 + ai * HALF + m * 16) * 2816 + col0;
                const f32x4 g0 = acc[ai][0][m][0], g1 = acc[ai][0][m][1], u0 = acc[ai][1][m][0], u1 = acc[ai][1][m][1];
                u32x4 w;
                w.x = cvt_pk_bf16(silu_f(g0[0]) * u0[0], silu_f(g0[1]) * u0[1]); w.y = cvt_pk_bf16(silu_f(g0[2]) * u0[2], silu_f(g0[3]) * u0[3]);
                w.z = cvt_pk_bf16(silu_f(g1[0]) * u1[0], silu_f(g1[1]) * u1[1]); w.w = cvt_pk_bf16(silu_f(g1[2]) * u1[2], silu_f(g1[3]) * u1[3]);
                __builtin_nontemporal_store(w, (u32x4*)rowp);
            }
    }
};
template <bool ATOMIC> struct EpiResid {
    static constexpr bool PERM = false, AFTER_DRAIN = false;
    float* X; const float* gate; float scale;
    __device__ __forceinline__ void operator()(const f32x4 (&acc)[2][2][4][2], const Unit& u, int wr, int wc, int fr, int fq) const {
        const int r0 = u.pm * BM; const int cidx = (r0 < 8192) ? 8 : ((r0 - 8192) >> 12);
        const float* gp = gate + (size_t)cidx * 9216;
        const int col0 = u.pn * BM + wc * 32 + 4 * fq;
#pragma unroll
        for (int bj = 0; bj < 2; ++bj)
#pragma unroll
            for (int n = 0; n < 2; ++n) {
                const f32x4 gv = *(const f32x4*)(gp + col0 + bj * HALF + n * 16) * scale;
#pragma unroll
                for (int ai = 0; ai < 2; ++ai)
#pragma unroll
                    for (int m = 0; m < 4; ++m) {
                        float* p = X + (size_t)(r0 + ai * HALF + wr * 64 + m * 16 + fr) * 1024 + col0 + bj * HALF + n * 16;
                        if (ATOMIC) { const f32x4 dlt = gv * acc[ai][bj][m][n];
#pragma unroll
                            for (int j = 0; j < 4; ++j) unsafeAtomicAdd(p + j, dlt[j]); }
                        else { f32x4 x = *(f32x4*)p; x = x + gv * acc[ai][bj][m][n]; *(f32x4*)p = x; }
                    }
            }
    }
};
template <int MODE> struct EpiProj {
    static constexpr bool PERM = true, AFTER_DRAIN = false;
    bf16_t* P; bf16_t* Vt; const float* ropec; const float* ropes; float* outK; float* outV; int jl;
    __device__ __forceinline__ void operator()(const f32x4 (&acc)[2][2][4][2], const Unit& u, int wr, int wc, int fr, int fq) const {
        constexpr int LDP = MODE == 0 ? 2816 : 2048;
        const int r0 = u.pm * BM; const bool prompt = r0 < 8192;
#pragma unroll
        for (int bj = 0; bj < 2; ++bj) {
            const int seg = 2 * u.pn + bj;
            int kind;
            int kbase, vbase, okw;
            if (MODE == 0) { kind = seg < 4 ? 1 : seg == 4 ? 2 : seg == 5 ? 3 : seg <= 20 ? 0 : 4; kbase = 512; vbase = 640; okw = 128; }
            else { kind = seg < 8 ? 1 : seg < 16 ? 2 : 3; kbase = 1024; vbase = 2048; okw = 1024; }
            if (kind == 4) continue;
            const int cseg = seg * 128 + wc * 32 + 8 * fq;
#pragma unroll
            for (int ai = 0; ai < 2; ++ai)
#pragma unroll
                for (int m = 0; m < 4; ++m) {
                    const int r = r0 + ai * HALF + wr * 64 + m * 16 + fr;
                    f32x4 v0 = acc[ai][bj][m][0], v1 = acc[ai][bj][m][1];
                    if ((kind == 2 || kind == 3) && prompt) {
                        float* o = (kind == 2 ? outK : outV) + ((size_t)((r >> 8) * 2 + jl) * 256 + (r & 255)) * okw + (cseg - (kind == 2 ? kbase : vbase));
                        *(f32x4*)o = v0; *(f32x4*)(o + 4) = v1;
                    }
                    if ((kind == 1 || kind == 2) && !prompt) {
                        const int t = (r - 8192) & 4095; const int pos = (wc & 1) ? (t & 63) : (t >> 6);
                        const float sg = (fq < 2) ? -1.0f : 1.0f;
                        { const f32x4 c0 = *(const f32x4*)(ropec + pos * 16 + 8 * (fq & 1)), s0 = *(const f32x4*)(ropes + pos * 16 + 8 * (fq & 1)); f32x4 p0;
#pragma unroll
                          for (int j = 0; j < 4; ++j) p0[j] = __shfl_xor(v0[j], 32);
                          v0 = v0 * c0 + (p0 * s0) * sg; }
                        { const f32x4 c1 = *(const f32x4*)(ropec + pos * 16 + 8 * (fq & 1) + 4), s1 = *(const f32x4*)(ropes + pos * 16 + 8 * (fq & 1) + 4); f32x4 p1;
#pragma unroll
                          for (int j = 0; j < 4; ++j) p1[j] = __shfl_xor(v1[j], 32);
                          v1 = v1 * c1 + (p1 * s1) * sg; }
                    }
                    if (kind == 3) {
                        bf16_t* vp = Vt + (size_t)(cseg - vbase) * ::MTOK + r;
#pragma unroll
                        for (int j = 0; j < 4; ++j) { vp[(size_t)j * ::MTOK] = (bf16_t)(cvt_pk_bf16(v0[j], 0.f) & 0xffffu); vp[(size_t)(j + 4) * ::MTOK] = (bf16_t)(cvt_pk_bf16(v1[j], 0.f) & 0xffffu); }
                    } else {
                        u32x4 w; w.x = cvt_pk_bf16(v0[0], v0[1]); w.y = cvt_pk_bf16(v0[2], v0[3]); w.z = cvt_pk_bf16(v1[0], v1[1]); w.w = cvt_pk_bf16(v1[2], v1[3]);
                        *(u32x4*)(P + (size_t)r * LDP + cseg) = w;
                    }
                    asm volatile("" ::: "memory");
                }
        }
    }
};
template <class Epi, class Sched, bool ALIGN_EPI = false, bool SP2 = false>
__device__ __forceinline__ void gemm_phase(PG8_LAS unsigned char* lds, const Gemm g, const Sched& S, const Epi& E, const int tid) {
    const int wid = __builtin_amdgcn_readfirstlane(tid >> 6), lane = tid & 63, wr = wid >> 2, wc = wid & 3, fr = lane & 15, fq = lane >> 4;
    const int K = g.ld, nt = g.K / BK;
    const size_t qstep = (size_t)g.K * 2;
    unsigned voffA[2], voffB[2];
#pragma unroll
    for (int i = 0; i < 2; ++i) { int R, C; stage_rc(tid * 16 + i * 8192, R, C); const int Rb = Epi::PERM ? ((R & ~31) + perm32(R & 31)) : R;
        voffA[i] = (unsigned)(R * K + C) * 2u; voffB[i] = (unsigned)(Rb * K + C) * 2u; }
    const size_t kstep = (size_t)(BK * 2);
    const size_t hstep = (size_t)HALF * K * 2;
    const size_t tstep = 2 * hstep;
    const unsigned ldsw = (unsigned)wid * 1024u;
    const int aoff = lds_byte(wr * 64 + fr, fq * 8), boff = lds_byte(wc * 32 + fr, fq * 8);
#define PG8_SA(b, h) (((b) * 2 + (h)) * HTB)
#define PG8_SB(b, h) ((4 + (b) * 2 + (h)) * HTB)
#define PG8_STAGE(bufoff, gbase, voff) do { _Pragma("unroll") for (int _i = 0; _i < 2; ++_i) \
        __builtin_amdgcn_global_load_lds((const unsigned*)((const char*)(gbase) + (voff)[_i]), (PG8_LAS unsigned*)(lds + (bufoff) + ldsw + _i * 8192), 16, 0, 0); } while (0)
#define PG8_LDA(dst, b, h) do { _Pragma("unroll") for (int m = 0; m < 4; ++m) _Pragma("unroll") for (int k = 0; k < 2; ++k) dst[m][k] = *(const PG8_LAS bf16x8*)(lds + PG8_SA(b, h) + aoff + m * 2048 + k * 1024); } while (0)
#define PG8_LDB(dst, b, h) do { _Pragma("unroll") for (int n = 0; n < 2; ++n) _Pragma("unroll") for (int k = 0; k < 2; ++k) dst[n][k] = *(const PG8_LAS bf16x8*)(lds + PG8_SB(b, h) + boff + n * 2048 + k * 1024); } while (0)
#define PG8_MMA(ai, bj, At, Bt) do { __builtin_amdgcn_s_setprio(1); _Pragma("unroll") for (int m = 0; m < 4; ++m) _Pragma("unroll") for (int n = 0; n < 2; ++n) _Pragma("unroll") for (int k = 0; k < 2; ++k) \
        acc[ai][bj][m][n] = __builtin_amdgcn_mfma_f32_16x16x32_bf16(Bt[n][k], At[m][k], acc[ai][bj][m][n], 0, 0, 0); __builtin_amdgcn_s_setprio(0); } while (0)
#define PG8_WAIT_V(n) asm volatile("s_waitcnt vmcnt(" #n ")" ::: "memory")
#define PG8_WAIT_L(n) asm volatile("s_waitcnt lgkmcnt(" #n ")" ::: "memory")
#define PG8_BAR __builtin_amdgcn_s_barrier()
#define PG8_SCHED __builtin_amdgcn_sched_barrier(0)
    Unit cur, nxt; int ui = 0;
    float zf_ = 0.f; asm volatile("" : "+v"(zf_));
    if (!S.next(0, cur)) return;
    f32x4 acc[2][2][4][2];
#pragma unroll
    for (int a = 0; a < 2; ++a)
#pragma unroll
        for (int b = 0; b < 2; ++b)
#pragma unroll
            for (int m = 0; m < 4; ++m)
#pragma unroll
                for (int n = 0; n < 2; ++n) acc[a][b][m][n] = (f32x4){zf_, zf_, zf_, zf_};
    bf16x8 At[4][2], B0[2][2], B1[2][2];
    const char* cA = (const char*)g.A + (size_t)cur.pm * tstep + (size_t)cur.kq * qstep; const char* cB = (const char*)g.Bt + (size_t)cur.pn * tstep + (size_t)cur.kq * qstep;
    S.a_ready(cur);
    if constexpr (SP2) {
        PG8_STAGE(PG8_SB(0, 0), cB, voffB); PG8_STAGE(PG8_SB(0, 1), cB + hstep, voffB); PG8_STAGE(PG8_SA(0, 0), cA, voffA); PG8_STAGE(PG8_SA(0, 1), cA + hstep, voffA);
        if (wr == 1) PG8_BAR;
        PG8_WAIT_V(2); PG8_BAR;
        PG8_STAGE(PG8_SB(1, 0), cB + kstep, voffB); PG8_STAGE(PG8_SA(1, 0), cA + kstep, voffA); PG8_STAGE(PG8_SB(1, 1), cB + hstep + kstep, voffB);
        PG8_WAIT_V(6); PG8_BAR;
    } else {
        PG8_STAGE(PG8_SB(0, 0), cB, voffB); PG8_STAGE(PG8_SA(0, 0), cA, voffA); PG8_STAGE(PG8_SB(0, 1), cB + hstep, voffB); PG8_STAGE(PG8_SA(0, 1), cA + hstep, voffA);
        if (wr == 1) PG8_BAR;
        PG8_WAIT_V(4); PG8_BAR;
        PG8_STAGE(PG8_SB(1, 0), cB + kstep, voffB); PG8_STAGE(PG8_SA(1, 0), cA + kstep, voffA); PG8_STAGE(PG8_SB(1, 1), cB + hstep + kstep, voffB);
        PG8_WAIT_V(6); PG8_BAR;
    }
    for (;;) {
        const bool has_next = S.next(ui + 1, nxt);
        const char* nA = has_next ? (const char*)g.A + (size_t)nxt.pm * tstep + (size_t)nxt.kq * qstep : cA; const char* nB = has_next ? (const char*)g.Bt + (size_t)nxt.pn * tstep + (size_t)nxt.kq * qstep : cB;
        for (int t = 0; t < nt; t += 2) {
            const bool last = (t == nt - 2);
            const char* a1 = cA + (size_t)(t + 1) * kstep;
            const char* a2 = last ? nA : cA + (size_t)(t + 2) * kstep; const char* b2 = last ? nB : cB + (size_t)(t + 2) * kstep;
            const char* a3 = a2 + kstep; const char* b3 = b2 + kstep;
            if (last && has_next) S.a_ready(nxt);
            if constexpr (SP2) {
            PG8_LDB(B0, 0, 0); PG8_LDB(B1, 0, 1); PG8_SCHED; PG8_LDA(At, 0, 0); PG8_STAGE(PG8_SA(1, 1), a1 + hstep, voffA);
            PG8_WAIT_V(8); PG8_WAIT_L(0); PG8_BAR; PG8_MMA(0, 0, At, B0); PG8_MMA(0, 1, At, B1); PG8_BAR; PG8_SCHED;
            PG8_LDA(At, 0, 1); PG8_STAGE(PG8_SB(0, 0), b2, voffB); PG8_STAGE(PG8_SB(0, 1), b2 + hstep, voffB); PG8_STAGE(PG8_SA(0, 0), a2, voffA);
            PG8_WAIT_V(8); PG8_WAIT_L(0); PG8_BAR; PG8_MMA(1, 0, At, B0); PG8_MMA(1, 1, At, B1); PG8_BAR; PG8_SCHED;
            PG8_LDB(B0, 1, 0); PG8_LDB(B1, 1, 1); PG8_SCHED; PG8_LDA(At, 1, 0); PG8_STAGE(PG8_SA(0, 1), a2 + hstep, voffA);
            PG8_WAIT_V(8); PG8_WAIT_L(0); PG8_BAR; PG8_MMA(0, 0, At, B0); PG8_MMA(0, 1, At, B1); PG8_BAR; PG8_SCHED;
            PG8_LDA(At, 1, 1); PG8_STAGE(PG8_SB(1, 0), b3, voffB); PG8_STAGE(PG8_SB(1, 1), b3 + hstep, voffB); PG8_STAGE(PG8_SA(1, 0), a3, voffA);
            PG8_WAIT_V(8); PG8_WAIT_L(0); PG8_BAR; PG8_MMA(1, 0, At, B0); PG8_MMA(1, 1, At, B1); PG8_BAR; PG8_SCHED;
            } else {
            PG8_LDB(B0, 0, 0); PG8_SCHED; PG8_LDA(At, 0, 0); PG8_STAGE(PG8_SA(1, 1), a1 + hstep, voffA);
            PG8_WAIT_L(8); PG8_BAR; PG8_WAIT_L(0); PG8_MMA(0, 0, At, B0); PG8_BAR; PG8_SCHED;
            PG8_LDB(B1, 0, 1); PG8_STAGE(PG8_SB(0, 0), b2, voffB);
            PG8_BAR; PG8_WAIT_L(0); PG8_MMA(0, 1, At, B1); PG8_BAR;
            PG8_LDA(At, 0, 1); PG8_STAGE(PG8_SA(0, 0), a2, voffA);
            PG8_BAR; PG8_WAIT_L(0); PG8_MMA(1, 0, At, B0); PG8_BAR; PG8_SCHED;
            PG8_STAGE(PG8_SB(0, 1), b2 + hstep, voffB);
            PG8_WAIT_V(6); PG8_BAR; PG8_MMA(1, 1, At, B1); PG8_BAR;
            PG8_LDB(B0, 1, 0); PG8_SCHED; PG8_LDA(At, 1, 0); PG8_STAGE(PG8_SA(0, 1), a2 + hstep, voffA);
            PG8_WAIT_L(8); PG8_BAR; PG8_WAIT_L(0); PG8_MMA(0, 0, At, B0); PG8_BAR; PG8_SCHED;
            PG8_LDB(B1, 1, 1); PG8_STAGE(PG8_SB(1, 0), b3, voffB);
            PG8_BAR; PG8_WAIT_L(0); PG8_MMA(0, 1, At, B1); PG8_BAR;
            PG8_LDA(At, 1, 1); PG8_STAGE(PG8_SA(1, 0), a3, voffA);
            PG8_BAR; PG8_WAIT_L(0); PG8_MMA(1, 0, At, B0); PG8_BAR; PG8_SCHED;
            PG8_STAGE(PG8_SB(1, 1), b3 + hstep, voffB);
            PG8_WAIT_V(6); PG8_BAR; PG8_MMA(1, 1, At, B1); PG8_BAR;
            }
        }
        if constexpr (ALIGN_EPI) { if (wr == 0) PG8_BAR; }
        if constexpr (!Epi::AFTER_DRAIN) { E(acc, cur, wr, wc, fr, fq); S.done(cur); }
        if (!has_next) break;
#pragma unroll
        for (int a = 0; a < 2; ++a)
#pragma unroll
            for (int b = 0; b < 2; ++b)
#pragma unroll
                for (int m = 0; m < 4; ++m)
#pragma unroll
                    for (int n = 0; n < 2; ++n) acc[a][b][m][n] = (f32x4){zf_, zf_, zf_, zf_};
        cur = nxt; cA = nA; cB = nB; ++ui;
        if constexpr (ALIGN_EPI) { if (wr == 1) PG8_BAR; }
    }
    PG8_WAIT_V(0);
    if constexpr (!ALIGN_EPI) { if (wr == 0) PG8_BAR; }
    PG8_BAR;
    if constexpr (Epi::AFTER_DRAIN) { E.fused(acc, cur, wr, wc, fr, fq, lds, wid, lane); S.done(cur); }
#undef PG8_SA
#undef PG8_SB
#undef PG8_STAGE
#undef PG8_LDA
#undef PG8_LDB
#undef PG8_MMA
#undef PG8_WAIT_V
#undef PG8_WAIT_L
#undef PG8_BAR
#undef PG8_SCHED
}
}
#define LAS __attribute__((address_space(3)))
typedef unsigned short bf16;
typedef float f32x4 __attribute__((ext_vector_type(4)));
typedef float f32x16 __attribute__((ext_vector_type(16)));
typedef short bf16x8 __attribute__((ext_vector_type(8)));
typedef short s16x4 __attribute__((ext_vector_type(4)));
typedef unsigned u32x4 __attribute__((ext_vector_type(4)));
typedef unsigned u32x2 __attribute__((ext_vector_type(2)));
#define MFMA32(a, b, c) __builtin_amdgcn_mfma_f32_32x32x16_bf16((a), (b), (c), 0, 0, 0)
__device__ __forceinline__ unsigned f2bf(float f) { unsigned u = __builtin_bit_cast(unsigned, f); return (u + 0x7fffu + ((u >> 16) & 1u)) >> 16; }
typedef float f32x2_t __attribute__((ext_vector_type(2))); typedef __bf16 bf16x2_t __attribute__((ext_vector_type(2)));
__device__ __forceinline__ unsigned pk2(float lo, float hi) { const f32x2_t v = {lo, hi}; const bf16x2_t q = __builtin_convertvector(v, bf16x2_t); return __builtin_bit_cast(unsigned, q); }
__device__ __forceinline__ float bf2f(unsigned short b) { return __builtin_bit_cast(float, (unsigned)b << 16); }
__device__ __forceinline__ int crow(int reg, int h) { return (reg & 3) + 8 * (reg >> 2) + 4 * h; }
__device__ __forceinline__ float wave_sum(float v) {
#pragma unroll
    for (int o = 1; o < 64; o <<= 1) v += __shfl_xor(v, o);
    return v;
}
constexpr size_t MiB = 1u << 20;
constexpr size_t WS_MOD = 1 * MiB;
constexpr size_t WS_ROPE = 3 * MiB;
constexpr size_t WS_BC = 4 * MiB;
constexpr size_t WS_W13 = 8 * MiB;
constexpr size_t WS_W2 = WS_W13 + 88 * MiB;
constexpr size_t WS_WAB = WS_W2 + 44 * MiB;
constexpr size_t WS_WABO = WS_WAB + 11 * MiB;
constexpr size_t WS_WC = WS_WABO + 4 * MiB;
constexpr size_t WS_WCO = WS_WC + 12 * MiB;
constexpr size_t WS_KAC = WS_WCO + 4 * MiB;
constexpr size_t WS_VAC = WS_KAC + 2 * MiB;
constexpr size_t WS_KCC = WS_VAC + 2 * MiB;
constexpr size_t WS_VCC = WS_KCC + 16 * MiB;
constexpr size_t WS_H = WS_VCC + 16 * MiB;
constexpr size_t WS_Y = WS_H + 80 * MiB;
constexpr size_t WS_G = WS_Y + 80 * MiB;
constexpr size_t WS_END = WS_G + 240 * MiB;
constexpr size_t G_VTA = (size_t)MTOK * 2816 * 2;
constexpr size_t G_VTC = (size_t)MTOK * 2048 * 2;
static_assert(G_VTA + (size_t)128 * MTOK * 2 <= 240 * MiB && G_VTC + (size_t)1024 * MTOK * 2 <= 240 * MiB, "G region");

struct Args {
    const float* in[38]; float* out; unsigned char* ws; int ph_lo, ph_hi;
};
struct Frame {
    LAS unsigned char* lds; int tid, lane, wave, G, bid;
    const float* const* in; float* out; unsigned char* ws;
};
constexpr size_t O_YP = 0, O_YS = (size_t)MPR * DM, O_AK = (size_t)MTOK * DM, O_AV = O_AK + (size_t)32 * 2 * 256 * 128, O_BW = O_AV + (size_t)32 * 2 * 256 * 128,
                 O_CK = O_BW + (size_t)32 * 2 * 2 * 8 * 64 * 64, O_CV = O_CK + (size_t)32 * 2 * 256 * 1024, O_END = O_CV + (size_t)32 * 2 * 256 * 1024;
enum { I_XP = 0, I_XS, I_C, I_CCTX, I_CAK, I_CAV, I_SB, I_CCK, I_CCV, I_NORMS, I_MODW, I_MODB, I_W1, I_W3, I_W2, I_WINAB, I_WOUTAB, I_SINK, I_MUP, I_MUN,
       I_BW0, I_BW2, I_BA0, I_BA2, I_BKK, I_BKA, I_BRK, I_BG2, I_GNW, I_GNB, I_WINC, I_WOUTC, I_LQ1, I_LK1, I_LQ2, I_LK2, I_SUBLN, I_FNORM };

__device__ __forceinline__ void transpose_item(const float* W, int K, int N, bf16* WT, int k0, int n0, int drow0, LAS float* scr, int lane) {
#pragma unroll 8
    for (int i = 0; i < 32; ++i) { const int kk = 2 * i + (lane >> 5); scr[kk * 33 + (lane & 31)] = W[(size_t)(k0 + kk) * N + n0 + (lane & 31)]; }
    asm volatile("s_waitcnt lgkmcnt(0)" ::: "memory");
    const int c = lane & 7;
#pragma unroll
    for (int j = 0; j < 4; ++j) { const int n = (lane >> 3) + 8 * j; const LAS float* s = scr + (8 * c) * 33 + n;
        u32x4 o; o.x = pk2(s[0 * 33], s[1 * 33]); o.y = pk2(s[2 * 33], s[3 * 33]); o.z = pk2(s[4 * 33], s[5 * 33]); o.w = pk2(s[6 * 33], s[7 * 33]);
        *(u32x4*)(WT + (size_t)(drow0 + n) * K + k0 + 8 * c) = o; }
    asm volatile("s_waitcnt lgkmcnt(0)" ::: "memory");
}
__device__ __forceinline__ void prologue(Frame& F) {
    unsigned char* ws = F.ws;
    LAS float* scr = (LAS float*)(F.lds + F.wave * 16384);
    const int gw = F.bid * 8 + F.wave, NGW = F.G * 8;
    const int gt = F.bid * 512 + F.tid, NGT = F.G * 512;
    constexpr int IT_W1 = 16 * 88, IT_W2 = 44 * 32, IT_AB = 16 * 84, IT_SQ = 16 * 32, IT_C = 16 * 96, IT_AV = 8 * 4, IT_CV = 8 * 32;
    constexpr int E0 = 8 * IT_W1, E1 = E0 + 8 * IT_W1, E2 = E1 + 8 * IT_W2, E3 = E2 + 2 * IT_AB, E4 = E3 + 2 * IT_SQ, E5 = E4 + 2 * IT_C, E6 = E5 + 2 * IT_SQ, E7 = E6 + 16 * IT_AV, E8a = E7 + 16 * IT_CV, E8b = E8a + 4 * 16, E8 = E8b + 4 * 16;
    for (int it = gw; it < E8; it += NGW) {
        const float* W; bf16* WT; int K, N, r, mode = 0;
        if (it < E0) { r = it; const int mi = r / IT_W1; r %= IT_W1; W = F.in[I_W1] + (size_t)mi * 1024 * 2816; WT = (bf16*)(ws + WS_W13) + (size_t)mi * 5632 * 1024; K = 1024; N = 2816; mode = 1; }
        else if (it < E1) { r = it - E0; const int mi = r / IT_W1; r %= IT_W1; W = F.in[I_W3] + (size_t)mi * 1024 * 2816; WT = (bf16*)(ws + WS_W13) + (size_t)mi * 5632 * 1024; K = 1024; N = 2816; mode = 2; }
        else if (it < E2) { r = it - E1; const int mi = r / IT_W2; r %= IT_W2; W = F.in[I_W2] + (size_t)mi * 2816 * 1024; WT = (bf16*)(ws + WS_W2) + (size_t)mi * 1024 * 2816; K = 2816; N = 1024; }
        else if (it < E3) { r = it - E2; const int mi = r / IT_AB; r %= IT_AB; W = F.in[I_WINAB] + (size_t)mi * 1024 * 2688; WT = (bf16*)(ws + WS_WAB) + (size_t)mi * 2816 * 1024; K = 1024; N = 2688; }
        else if (it < E4) { r = it - E3; const int mi = r / IT_SQ; r %= IT_SQ; W = F.in[I_WOUTAB] + (size_t)mi * 1024 * 1024; WT = (bf16*)(ws + WS_WABO) + (size_t)mi * 1024 * 1024; K = 1024; N = 1024; }
        else if (it < E5) { r = it - E4; const int mi = r / IT_C; r %= IT_C; W = F.in[I_WINC] + (size_t)mi * 1024 * 3072; WT = (bf16*)(ws + WS_WC) + (size_t)mi * 3072 * 1024; K = 1024; N = 3072; }
        else if (it < E6) { r = it - E5; const int mi = r / IT_SQ; r %= IT_SQ; W = F.in[I_WOUTC] + (size_t)mi * 1024 * 1024; WT = (bf16*)(ws + WS_WCO) + (size_t)mi * 1024 * 1024; K = 1024; N = 1024; }
        else if (it < E7) { r = it - E6; const int mi = r / IT_AV; r %= IT_AV; W = F.in[I_CAV] + (size_t)mi * 512 * 128; WT = (bf16*)(ws + WS_VAC) + (size_t)mi * 128 * 512; K = 512; N = 128; }
        else if (it < E8a) { r = it - E7; const int mi = r / IT_CV; r %= IT_CV; W = F.in[I_CCV] + (size_t)mi * 512 * 1024; WT = (bf16*)(ws + WS_VCC) + (size_t)mi * 1024 * 512; K = 512; N = 1024; }
        else if (it < E8b) { r = it - E8a; const int mi = r / 16; r %= 16; W = F.in[I_BW2] + (size_t)mi * 64 * 512; WT = (bf16*)(ws + (7 * MiB)) + (size_t)mi * 512 * 64; K = 64; N = 512; }
        else { r = it - E8b; const int mi = r / 16; r %= 16; W = F.in[I_BA2] + (size_t)mi * 64 * 512; WT = (bf16*)(ws + (7 * MiB)) + (size_t)(4 + mi) * 512 * 64; K = 64; N = 512; }
        const int nblk = N / 32, kb = r / nblk, nb = r % nblk, k0 = 64 * kb, n0 = 32 * nb;
        int drow0 = n0;
        if (mode) drow0 = (n0 >> 7) * 256 + (n0 & 127) + (mode == 2 ? 128 : 0);
        transpose_item(W, K, N, WT, k0, n0, drow0, scr, F.lane);
    }
    unsigned z_ = 0u; asm volatile("" : "+v"(z_));
    for (int i = gt; i < 2 * 128 * 1024 / 8; i += NGT) { const int mi = i / (128 * 1024 / 8), o = i % (128 * 1024 / 8);
        *(u32x4*)((bf16*)(ws + WS_WAB) + (size_t)mi * 2816 * 1024 + (size_t)2688 * 1024 + (size_t)o * 8) = (u32x4){z_, z_, z_, z_}; }
    for (int i = gt; i < 8 * 2 * 512 * 128 / 4; i += NGT) { const f32x4 v = ((const f32x4*)F.in[I_CAK])[i]; ((u32x2*)(ws + WS_KAC))[i] = (u32x2){pk2(v[0], v[1]), pk2(v[2], v[3])}; }
    for (int i = gt; i < 8 * 2 * 512 * 1024 / 4; i += NGT) { const f32x4 v = ((const f32x4*)F.in[I_CCK])[i]; ((u32x2*)(ws + WS_KCC))[i] = (u32x2){pk2(v[0], v[1]), pk2(v[2], v[3])}; }
    if (gt < 1024) { const int pos = gt >> 4, i = gt & 15; const float inv = powf(10000.0f, -(float)i / 16.0f); const float ang = (float)pos * inv;
        ((float*)(ws + WS_ROPE))[gt] = cosf(ang); ((float*)(ws + WS_ROPE))[1024 + gt] = sinf(ang); }
    __syncthreads();
    LAS float* sc = (LAS float*)F.lds;
    LAS float* red = sc + 9 * 1024;
    for (int i = F.tid; i < 9 * 1024; i += 512) { const float v = i < 8192 ? F.in[I_C][i] : F.in[I_CCTX][i - 8192]; sc[i] = v / (1.0f + __expf(-v)); }
    __syncthreads();
    for (int it = F.bid; it < 4 * 144; it += F.G) {
        const int l = it / 144, n0 = (it % 144) * 64;
        const float* W = F.in[I_MODW] + (size_t)l * 1024 * 9216 + n0 + F.lane;
        float a[9];
#pragma unroll
        for (int c = 0; c < 9; ++c) a[c] = 0.f;
        const int kb = F.wave * 128;
#pragma unroll 16
        for (int k = 0; k < 128; ++k) { const float w = W[(size_t)(kb + k) * 9216];
#pragma unroll
            for (int c = 0; c < 9; ++c) a[c] += sc[c * 1024 + kb + k] * w; }
#pragma unroll
        for (int c = 0; c < 9; ++c) red[(F.wave * 9 + c) * 64 + F.lane] = a[c];
        __syncthreads();
        for (int i = F.tid; i < 576; i += 512) { const int c = i >> 6, n = i & 63; float s = F.in[I_MODB][(size_t)l * 9216 + n0 + n];
#pragma unroll
            for (int w = 0; w < 8; ++w) s += red[(w * 9 + c) * 64 + n];
            ((float*)(ws + WS_MOD))[((size_t)l * 9 + c) * 9216 + n0 + n] = s; }
        __syncthreads();
    }
}
__device__ __forceinline__ void norm_phase(Frame& F, int l, int s) {
    const float* g = F.in[I_NORMS] + (size_t)(l * 3 + s) * 1024;
    const float* mod = (const float*)(F.ws + WS_MOD) + (size_t)l * 9 * 9216;
    bf16* H = (bf16*)(F.ws + WS_H);
    const int gw = F.bid * 8 + F.wave, NGW = F.G * 8;
    for (int m2 = gw; m2 < MTOK / 2; m2 += NGW) {
        const int m = 2 * m2;
        const int cidx = m < MPR ? 8 : ((m - MPR) >> 12);
        const float* sh = mod + (size_t)cidx * 9216 + (3 * s) * 1024; const float* scp = sh + 1024;
        const bool first = (l == 0 && s == 0);
        const float* xsrc = first ? (m < MPR ? F.in[I_XP] + (size_t)m * 1024 : F.in[I_XS] + (size_t)(m - MPR) * 1024) : F.out + (size_t)m * 1024;
        const f32x4* xr = (const f32x4*)xsrc + F.lane;
        f32x4 v[8]; float ss0 = 0.f, ss1 = 0.f;
#pragma unroll
        for (int j = 0; j < 8; ++j) v[j] = xr[64 * j];
        if (first) { f32x4* xo = (f32x4*)(F.out + (size_t)m * 1024) + F.lane;
#pragma unroll
            for (int j = 0; j < 8; ++j) xo[64 * j] = v[j]; }
#pragma unroll
        for (int j = 0; j < 4; ++j) { ss0 += (v[j].x * v[j].x + v[j].y * v[j].y) + (v[j].z * v[j].z + v[j].w * v[j].w); ss1 += (v[4 + j].x * v[4 + j].x + v[4 + j].y * v[4 + j].y) + (v[4 + j].z * v[4 + j].z + v[4 + j].w * v[4 + j].w); }
        const float rstd0 = 1.0f / sqrtf(wave_sum(ss0) * (1.0f / 1024.0f) + 1e-6f), rstd1 = 1.0f / sqrtf(wave_sum(ss1) * (1.0f / 1024.0f) + 1e-6f);
        u32x2* o = (u32x2*)(H + (size_t)m * 1024) + F.lane;
#pragma unroll
        for (int j = 0; j < 4; ++j) { const int c = 4 * F.lane + 256 * j; const f32x4 gg = *(const f32x4*)(g + c), s4 = *(const f32x4*)(scp + c) + 1.0f, h4 = *(const f32x4*)(sh + c);
            const f32x4 y0 = (v[j] * rstd0) * gg * s4 + h4, y1 = (v[4 + j] * rstd1) * gg * s4 + h4;
            __builtin_nontemporal_store((u32x2){pk2(y0.x, y0.y), pk2(y0.z, y0.w)}, &o[64 * j]); __builtin_nontemporal_store((u32x2){pk2(y1.x, y1.y), pk2(y1.z, y1.w)}, &o[256 + 64 * j]); }
    }
}
__device__ __forceinline__ void final_norm_phase(Frame& F) {
    const float* g = F.in[I_FNORM];
    const int gw = F.bid * 8 + F.wave, NGW = F.G * 8;
    for (int m = gw; m < MTOK; m += NGW) {
        f32x4* xr = (f32x4*)(F.out + (size_t)m * 1024) + F.lane;
        f32x4 v[4]; float ss = 0.f;
#pragma unroll
        for (int j = 0; j < 4; ++j) { v[j] = xr[64 * j]; ss += (v[j].x * v[j].x + v[j].y * v[j].y) + (v[j].z * v[j].z + v[j].w * v[j].w); }
        const float rstd = 1.0f / sqrtf(wave_sum(ss) * (1.0f / 1024.0f) + 1e-6f);
#pragma unroll
        for (int j = 0; j < 4; ++j) { const int c = 4 * F.lane + 256 * j; xr[64 * j] = (v[j] * rstd) * *(const f32x4*)(g + c); }
    }
}
struct KSeg { const bf16* K; long ks; const bf16* Vt; long vs; int k_lo, k_hi; int win; };
template <int NMAP, int DV>
struct AttnState { f32x16 o[NMAP][DV / 32]; float m[NMAP], l[NMAP]; };

template <int NMAP, int DV, bool QL>
__device__ __forceinline__ void attn_seg(AttnState<NMAP, DV>& st, const bf16x8 (&qf)[NMAP][4], const LAS bf16x8* ql, const KSeg& sg, int q0, int lane) {
    const int r = lane & 31, h = lane >> 5;
    constexpr float SC = 0.125f * 1.4426950408889634f;
    for (int k0 = sg.k_lo; k0 < sg.k_hi; k0 += 32) {
        bf16x8 pf[NMAP][2];
#pragma unroll
        for (int mp = 0; mp < NMAP; ++mp) {
            const bf16* kp = sg.K + (long)(k0 + r) * sg.ks + mp * 64 + 8 * h;
            f32x16 s;
#pragma unroll
            for (int i = 0; i < 16; ++i) s[i] = 0.f;
#pragma unroll
            for (int ks = 0; ks < 4; ++ks) { const bf16x8 kf = *(const bf16x8*)(kp + 16 * ks); const bf16x8 qv = QL ? ql[(mp * 4 + ks) * 64 + lane] : qf[mp][ks]; s = MFMA32(kf, qv, s); }
            float mx = -INFINITY;
#pragma unroll
            for (int i = 0; i < 16; ++i) { float v = s[i] * SC;
                if (sg.win) { const int d = k0 + crow(i, h) - (q0 + r); if (d > 128 || d < -128) v = -INFINITY; }
                s[i] = v; mx = fmaxf(mx, v); }
            mx = fmaxf(mx, __shfl_xor(mx, 32));
            const float mn = fmaxf(st.m[mp], mx); const float ms = (mn == -INFINITY) ? 0.f : mn;
            const float alpha = __builtin_amdgcn_exp2f(st.m[mp] - ms);
            st.m[mp] = mn;
            float ps = 0.f;
#pragma unroll
            for (int i = 0; i < 16; ++i) { s[i] = __builtin_amdgcn_exp2f(s[i] - ms); ps += s[i]; }
            st.l[mp] = st.l[mp] * alpha + ps;
#pragma unroll
            for (int dt = 0; dt < DV / 32; ++dt)
#pragma unroll
                for (int i = 0; i < 16; ++i) st.o[mp][dt][i] *= alpha;
#pragma unroll
            for (int s2 = 0; s2 < 2; ++s2) { u32x4 w; w.x = pk2(s[8 * s2], s[8 * s2 + 1]); w.y = pk2(s[8 * s2 + 2], s[8 * s2 + 3]); w.z = pk2(s[8 * s2 + 4], s[8 * s2 + 5]); w.w = pk2(s[8 * s2 + 6], s[8 * s2 + 7]);
                pf[mp][s2] = __builtin_bit_cast(bf16x8, w); }
            asm volatile("" ::: "memory");
        }
#pragma unroll
        for (int dt = 0; dt < DV / 32; ++dt) {
            const bf16* vp = sg.Vt + (long)(dt * 32 + r) * sg.vs + k0 + 4 * h;
#pragma unroll
            for (int s2 = 0; s2 < 2; ++s2) {
                const s16x4 lo = *(const s16x4*)(vp + 16 * s2), hi = *(const s16x4*)(vp + 16 * s2 + 8);
                const bf16x8 vf = __builtin_shufflevector(lo, hi, 0, 1, 2, 3, 4, 5, 6, 7);
#pragma unroll
                for (int mp = 0; mp < NMAP; ++mp) st.o[mp][dt] = MFMA32(vf, pf[mp][s2], st.o[mp][dt]);
            }
            asm volatile("" ::: "memory");
        }
    }
}
template <int NMAP, int DV>
__device__ __forceinline__ void attn_init(AttnState<NMAP, DV>& st) {
#pragma unroll
    for (int mp = 0; mp < NMAP; ++mp) { st.m[mp] = -INFINITY; st.l[mp] = 0.f;
#pragma unroll
        for (int dt = 0; dt < DV / 32; ++dt)
#pragma unroll
            for (int i = 0; i < 16; ++i) st.o[mp][dt][i] = 0.f; }
}
__device__ __forceinline__ void load_q(bf16x8 (&qf)[4], const bf16* q, int lane) {
#pragma unroll
    for (int ks = 0; ks < 4; ++ks) qf[ks] = *(const bf16x8*)(q + 16 * ks + 8 * (lane >> 5));
}
__device__ __forceinline__ bf16x8 pack8a(const f32x16& x, int s2) {
    u32x4 w; w.x = pk2(x[8 * s2], x[8 * s2 + 1]); w.y = pk2(x[8 * s2 + 2], x[8 * s2 + 3]); w.z = pk2(x[8 * s2 + 4], x[8 * s2 + 5]); w.w = pk2(x[8 * s2 + 6], x[8 * s2 + 7]);
    return __builtin_bit_cast(bf16x8, w);
}
__device__ __forceinline__ void attn_segA(AttnState<1, 64>& st, const bf16x8 (&qf)[4], const KSeg& sg, int q0, int lane) {
    const int r = lane & 31, h = lane >> 5;
    constexpr float SC = 0.125f * 1.4426950408889634f;
    if (sg.k_lo >= sg.k_hi) return;
    bf16x8 kf[4]; s16x4 vlo[2][2], vhi[2][2];
#define A_LOAD(K0) do { const bf16* kp_ = sg.K + (long)((K0) + r) * sg.ks + 8 * h; \
        _Pragma("unroll") for (int ks = 0; ks < 4; ++ks) kf[ks] = *(const bf16x8*)(kp_ + 16 * ks); \
        _Pragma("unroll") for (int dt = 0; dt < 2; ++dt) { const bf16* vp_ = sg.Vt + (long)(dt * 32 + r) * sg.vs + (K0) + 4 * h; \
            _Pragma("unroll") for (int s2 = 0; s2 < 2; ++s2) { vlo[dt][s2] = *(const s16x4*)(vp_ + 16 * s2); vhi[dt][s2] = *(const s16x4*)(vp_ + 16 * s2 + 8); } } } while (0)
    A_LOAD(sg.k_lo);
    for (int k0 = sg.k_lo; k0 < sg.k_hi; k0 += 32) {
        bf16x8 kc[4]; s16x4 cl[2][2], ch[2][2];
#pragma unroll
        for (int ks = 0; ks < 4; ++ks) kc[ks] = kf[ks];
#pragma unroll
        for (int dt = 0; dt < 2; ++dt)
#pragma unroll
            for (int s2 = 0; s2 < 2; ++s2) { cl[dt][s2] = vlo[dt][s2]; ch[dt][s2] = vhi[dt][s2]; }
        if (k0 + 32 < sg.k_hi) A_LOAD(k0 + 32);
        f32x16 s;
#pragma unroll
        for (int i = 0; i < 16; ++i) s[i] = 0.f;
#pragma unroll
        for (int ks = 0; ks < 4; ++ks) s = MFMA32(kc[ks], qf[ks], s);
        float mx = -INFINITY;
#pragma unroll
        for (int i = 0; i < 16; ++i) { float v = s[i] * SC;
            if (sg.win) { const int d = k0 + crow(i, h) - (q0 + r); if (d > 128 || d < -128) v = -INFINITY; }
            s[i] = v; mx = fmaxf(mx, v); }
        mx = fmaxf(mx, __shfl_xor(mx, 32));
        const float mn = fmaxf(st.m[0], mx); const float ms = (mn == -INFINITY) ? 0.f : mn;
        const float alpha = __builtin_amdgcn_exp2f(st.m[0] - ms);
        st.m[0] = mn;
        float ps = 0.f;
#pragma unroll
        for (int i = 0; i < 16; ++i) { s[i] = __builtin_amdgcn_exp2f(s[i] - ms); ps += s[i]; }
        st.l[0] = st.l[0] * alpha + ps;
#pragma unroll
        for (int dt = 0; dt < 2; ++dt)
#pragma unroll
            for (int i = 0; i < 16; ++i) st.o[0][dt][i] *= alpha;
        const bf16x8 p0 = pack8a(s, 0), p1 = pack8a(s, 1);
#pragma unroll
        for (int dt = 0; dt < 2; ++dt) {
            st.o[0][dt] = MFMA32(__builtin_shufflevector(cl[dt][0], ch[dt][0], 0, 1, 2, 3, 4, 5, 6, 7), p0, st.o[0][dt]);
            st.o[0][dt] = MFMA32(__builtin_shufflevector(cl[dt][1], ch[dt][1], 0, 1, 2, 3, 4, 5, 6, 7), p1, st.o[0][dt]);
        }
    }
#undef A_LOAD
}
__device__ __forceinline__ void attnA_phase(Frame& F, int jl) {
    const bf16* P = (const bf16*)(F.ws + WS_G); const bf16* VtA = (const bf16*)(F.ws + WS_G + G_VTA);
    bf16* O = (bf16*)(F.ws + WS_H);
    const int lane = F.lane, r = lane & 31, h = lane >> 5;
    constexpr int NU_L = 8 * 8 * 128, NU_P = 32 * 8 * 8;
    unsigned* ctr = (unsigned*)F.ws + 3600 + 64 * jl;
    for (;;) {
        unsigned ug = 0; if (lane == 0) ug = atomicAdd(ctr, 1u);
        const int u = (int)__builtin_amdgcn_readfirstlane(ug);
        if (u >= NU_L + NU_P) break;
        int m0, T, head, qb, b; bool latent = u < NU_L;
        if (latent) { b = u >> 10; head = (u >> 7) & 7; qb = u & 127; m0 = MPR + b * TL; T = TL; }
        else { const int v = u - NU_L; b = v >> 6; head = (v >> 3) & 7; qb = v & 7; m0 = b * TP; T = TP; }
        const int q0 = qb * 32, kvh = head >> 2;
        bf16x8 qf[1][4]; load_q(qf[0], P + (size_t)(m0 + q0 + r) * PLD_AB + head * 64, lane);
        AttnState<1, 64> st; attn_init(st);
        KSeg s1; s1.K = P + (size_t)m0 * PLD_AB + 512 + kvh * 64; s1.ks = PLD_AB; s1.Vt = VtA + (size_t)(kvh * 64) * MTOK + m0; s1.vs = MTOK;
        if (latent) {
            KSeg s0; s0.K = (const bf16*)(F.ws + WS_KAC) + (size_t)(b * 2 + jl) * 512 * 128 + kvh * 64; s0.ks = 128;
            s0.Vt = (const bf16*)(F.ws + WS_VAC) + (size_t)(b * 2 + jl) * 128 * 512 + (size_t)(kvh * 64) * 512; s0.vs = 512; s0.k_lo = 0; s0.k_hi = 512; s0.win = 0;
            attn_segA(st, qf[0], s0, q0, lane);
            s1.k_lo = q0 - 128 < 0 ? 0 : q0 - 128; s1.k_hi = q0 + 160 > T ? T : q0 + 160; s1.win = 1;
        } else { s1.k_lo = 0; s1.k_hi = T; s1.win = 0; }
        attn_segA(st, qf[0], s1, q0, lane);
        float l = st.l[0] + __shfl_xor(st.l[0], 32);
        l += __builtin_amdgcn_exp2f(F.in[I_SINK][jl * 8 + head] * 1.4426950408889634f - st.m[0]);
        const float rl = 1.0f / l;
        bf16* op = O + (size_t)(m0 + q0 + r) * 1024 + head * 64;
#pragma unroll
        for (int dt = 0; dt < 2; ++dt)
#pragma unroll
            for (int g = 0; g < 4; ++g) { const int d = dt * 32 + 8 * g + 4 * h;
                *(u32x2*)(op + d) = (u32x2){pk2(st.o[0][dt][4 * g] * rl, st.o[0][dt][4 * g + 1] * rl), pk2(st.o[0][dt][4 * g + 2] * rl, st.o[0][dt][4 * g + 3] * rl)}; }
    }
}
__device__ __forceinline__ void attnC_phase(Frame& F, int jl, int layer) {
    const bf16* P = (const bf16*)(F.ws + WS_G); const bf16* VtC = (const bf16*)(F.ws + WS_G + G_VTC);
    bf16* O = (bf16*)(F.ws + WS_H);
    const int lane = F.lane, r = lane & 31, h = lane >> 5;
    const int wk = F.bid * 8 + F.wave, nwk = F.G * 8;
    const float lam_init = 0.8f - 0.6f * expf(-0.3f * (float)layer);
    const float d1 = wave_sum(F.in[I_LQ1][jl * 64 + lane] * F.in[I_LK1][jl * 64 + lane]), d2 = wave_sum(F.in[I_LQ2][jl * 64 + lane] * F.in[I_LK2][jl * 64 + lane]);
    const float lam = expf(d1) - expf(d2) + lam_init;
    const float* subln = F.in[I_SUBLN] + jl * 128;
    LAS bf16x8* ql = (LAS bf16x8*)(F.lds + F.wave * 8192);
    constexpr int NU_L = 8 * 8 * 128, NU_P = 32 * 8 * 8;
    for (int u = wk; u < NU_L + NU_P; u += nwk) {
        int m0, T, head, qb, b; bool latent = u < NU_L;
        if (latent) { b = u >> 10; head = (u >> 7) & 7; qb = u & 127; m0 = MPR + b * TL; T = TL; }
        else { const int v = u - NU_L; b = v >> 6; head = (v >> 3) & 7; qb = v & 7; m0 = b * TP; T = TP; }
        const int q0 = qb * 32;
        bf16x8 qf[2][4];
        { bf16x8 qt[4]; load_q(qt, P + (size_t)(m0 + q0 + r) * PLD_C + head * 128, lane);
#pragma unroll
          for (int ks = 0; ks < 4; ++ks) ql[ks * 64 + lane] = qt[ks];
          load_q(qt, P + (size_t)(m0 + q0 + r) * PLD_C + head * 128 + 64, lane);
#pragma unroll
          for (int ks = 0; ks < 4; ++ks) ql[(4 + ks) * 64 + lane] = qt[ks]; }
        asm volatile("s_waitcnt lgkmcnt(0)" ::: "memory");
        AttnState<2, 128> st; attn_init(st);
        if (latent) {
            KSeg s0; s0.K = (const bf16*)(F.ws + WS_KCC) + (size_t)(b * 2 + jl) * 512 * 1024 + head * 128; s0.ks = 1024;
            s0.Vt = (const bf16*)(F.ws + WS_VCC) + (size_t)(b * 2 + jl) * 1024 * 512 + (size_t)(head * 128) * 512; s0.vs = 512; s0.k_lo = 0; s0.k_hi = 512; s0.win = 0;
            attn_seg<2, 128, true>(st, qf, ql, s0, q0, lane);
        }
        KSeg s1; s1.K = P + (size_t)m0 * PLD_C + 1024 + head * 128; s1.ks = PLD_C; s1.Vt = VtC + (size_t)(head * 128) * MTOK + m0; s1.vs = MTOK; s1.k_lo = 0; s1.k_hi = T; s1.win = 0;
        attn_seg<2, 128, true>(st, qf, ql, s1, q0, lane);
        const float l1 = st.l[0] + __shfl_xor(st.l[0], 32), l2 = st.l[1] + __shfl_xor(st.l[1], 32);
        const float r1 = 1.0f / l1, r2 = lam / l2;
        float ss = 0.f;
#pragma unroll
        for (int dt = 0; dt < 4; ++dt)
#pragma unroll
            for (int i = 0; i < 16; ++i) { const float v = st.o[0][dt][i] * r1 - st.o[1][dt][i] * r2; st.o[0][dt][i] = v; ss += v * v; }
        ss += __shfl_xor(ss, 32);
        const float rs = (1.0f / sqrtf(ss * (1.0f / 128.0f) + 1e-5f)) * (1.0f - lam_init);
        bf16* op = O + (size_t)(m0 + q0 + r) * 1024 + head * 128;
#pragma unroll
        for (int dt = 0; dt < 4; ++dt)
#pragma unroll
            for (int g = 0; g < 4; ++g) { const int d = dt * 32 + 8 * g + 4 * h; const f32x4 w = *(const f32x4*)(subln + d);
                *(u32x2*)(op + d) = (u32x2){pk2(st.o[0][dt][4 * g] * rs * w[0], st.o[0][dt][4 * g + 1] * rs * w[1]), pk2(st.o[0][dt][4 * g + 2] * rs * w[2], st.o[0][dt][4 * g + 3] * rs * w[3])}; }
    }
}
__device__ __forceinline__ bf16x8 pack8(const f32x16& x, int s2) {
    u32x4 w; w.x = pk2(x[8 * s2], x[8 * s2 + 1]); w.y = pk2(x[8 * s2 + 2], x[8 * s2 + 3]); w.z = pk2(x[8 * s2 + 4], x[8 * s2 + 5]); w.w = pk2(x[8 * s2 + 6], x[8 * s2 + 7]);
    return __builtin_bit_cast(bf16x8, w);
}
constexpr int KP = 136, VP = 36;
constexpr int C2_Q = 0, C2_K = 65536, C2_V = C2_K + 2 * 32 * KP * 2, C2_END = C2_V + 2 * 128 * VP * 2;
static_assert(C2_END <= 147456, "attnC2 LDS");
__device__ __forceinline__ void attnC2_phase(Frame& F, int jl, int layer) {
    const bf16* P = (const bf16*)(F.ws + WS_G); const bf16* VtC = (const bf16*)(F.ws + WS_G + G_VTC);
    bf16* O = (bf16*)(F.ws + WS_H);
    const float lam_init = 0.8f - 0.6f * expf(-0.3f * (float)layer);
    const float d1 = wave_sum(F.in[I_LQ1][jl * 64 + F.lane] * F.in[I_LK1][jl * 64 + F.lane]), d2 = wave_sum(F.in[I_LQ2][jl * 64 + F.lane] * F.in[I_LK2][jl * 64 + F.lane]);
    const float lam = expf(d1) - expf(d2) + lam_init;
    const float* subln = F.in[I_SUBLN] + jl * 128;
    LAS bf16x8* ql = (LAS bf16x8*)(F.lds + C2_Q + F.wave * 8192);
    constexpr float SC = 0.125f * 1.4426950408889634f;
    for (int u0 = F.bid; u0 < 1280; u0 += F.G) {
        int u = u0;
        if (F.G == 256 && u0 < 1024) { const int k = u0 >> 8, xcd = F.bid & 7, slot = F.bid >> 3; u = ((k * 16 + xcd * 2 + (slot >> 4)) << 4) + (slot & 15); }
        int lane = F.lane; asm volatile("" : "+v"(lane));
        const int tid = F.wave * 64 + lane, r = lane & 31, h = lane >> 5;
        int m0, T, head, b, qb; const bool latent = u < 1024;
        if (latent) { b = u >> 7; head = (u >> 4) & 7; qb = u & 15; m0 = MPR + b * TL; T = TL; } else { const int v = u - 1024; b = v >> 3; head = v & 7; qb = 0; m0 = b * TP; T = TP; }
        const int q0 = qb * 256 + F.wave * 32;
        bf16x8 qf0[4];
        load_q(qf0, P + (size_t)(m0 + q0 + r) * PLD_C + head * 128, lane);
        { bf16x8 qt[4]; load_q(qt, P + (size_t)(m0 + q0 + r) * PLD_C + head * 128 + 64, lane);
#pragma unroll
          for (int ks = 0; ks < 4; ++ks) ql[ks * 64 + lane] = qt[ks]; }
        AttnState<2, 128> st; attn_init(st);
        const int nctx = latent ? 16 : 0, ntile = nctx + T / 32;
        const bf16* kc = (const bf16*)(F.ws + WS_KCC) + (size_t)(b * 2 + jl) * 512 * 1024 + head * 128 + (size_t)(tid >> 4) * 1024 + (tid & 15) * 8;
        const bf16* vc = (const bf16*)(F.ws + WS_VCC) + (size_t)(b * 2 + jl) * 1024 * 512 + (size_t)(head * 128 + (tid >> 2)) * 512 + (tid & 3) * 8;
        const bf16* kl = P + (size_t)m0 * PLD_C + 1024 + head * 128 + (size_t)(tid >> 4) * PLD_C + (tid & 15) * 8;
        const bf16* vl = VtC + (size_t)(head * 128 + (tid >> 2)) * MTOK + m0 + (tid & 3) * 8;
        const int kw = (tid >> 4) * KP + (tid & 15) * 8, vw = (tid >> 2) * VP + (tid & 3) * 8;
        u32x4 kreg, vreg;
#define C2_LOAD(ti) do { if ((ti) < nctx) { kreg = *(const u32x4*)(kc + (size_t)(ti) * 32 * 1024); vreg = *(const u32x4*)(vc + (ti) * 32); } \
                         else { const int k0_ = ((ti) - nctx) * 32; kreg = *(const u32x4*)(kl + (size_t)k0_ * PLD_C); vreg = *(const u32x4*)(vl + k0_); } } while (0)
#define C2_STORE(bufi) do { *(LAS u32x4*)((LAS bf16*)(F.lds + C2_K) + (bufi) * 32 * KP + kw) = kreg; *(LAS u32x2*)((LAS bf16*)(F.lds + C2_V) + (bufi) * 128 * VP + vw) = (u32x2){vreg.x, vreg.y}; *(LAS u32x2*)((LAS bf16*)(F.lds + C2_V) + (bufi) * 128 * VP + vw + 4) = (u32x2){vreg.z, vreg.w}; } while (0)
        C2_LOAD(0); C2_STORE(0);
        asm volatile("s_waitcnt vmcnt(0) lgkmcnt(0)" ::: "memory"); __builtin_amdgcn_s_barrier(); asm volatile("" ::: "memory");
        for (int ti = 0; ti < ntile; ++ti) {
            const bool more = ti + 1 < ntile;
            if (more) C2_LOAD(ti + 1);
            const LAS bf16* Kb = (const LAS bf16*)(F.lds + C2_K) + (ti & 1) * 32 * KP; const LAS bf16* Vb = (const LAS bf16*)(F.lds + C2_V) + (ti & 1) * 128 * VP;
            bf16x8 pf[2][2];
#pragma unroll
            for (int mp = 0; mp < 2; ++mp) {
                f32x16 s;
#pragma unroll
                for (int i = 0; i < 16; ++i) s[i] = 0.f;
#pragma unroll
                for (int ks = 0; ks < 4; ++ks) { const bf16x8 kf = *(const LAS bf16x8*)(Kb + r * KP + mp * 64 + 16 * ks + 8 * h); s = MFMA32(kf, mp == 0 ? qf0[ks] : ql[ks * 64 + lane], s); }
                float mx = -INFINITY;
#pragma unroll
                for (int i = 0; i < 16; ++i) mx = fmaxf(mx, s[i]);
                mx = fmaxf(mx, __shfl_xor(mx, 32)) * SC;
                const float mn = (mx > st.m[mp] + 8.0f) ? mx : st.m[mp];
                const float alpha = __builtin_amdgcn_exp2f(st.m[mp] - mn);
                st.m[mp] = mn;
                float ps = 0.f;
#pragma unroll
                for (int i = 0; i < 16; ++i) { s[i] = __builtin_amdgcn_exp2f(__builtin_fmaf(s[i], SC, -mn)); ps += s[i]; }
                st.l[mp] = st.l[mp] * alpha + ps;
                if (__any(alpha != 1.0f)) {
#pragma unroll
                    for (int dt = 0; dt < 4; ++dt)
#pragma unroll
                        for (int i = 0; i < 16; ++i) st.o[mp][dt][i] *= alpha; }
                pf[mp][0] = pack8(s, 0); pf[mp][1] = pack8(s, 1);
                asm volatile("" ::: "memory");
            }
#pragma unroll
            for (int dt = 0; dt < 4; ++dt) {
#pragma unroll
                for (int s2 = 0; s2 < 2; ++s2) {
                    const LAS bf16* vp = Vb + (dt * 32 + r) * VP + 16 * s2 + 4 * h;
                    const s16x4 lo = *(const LAS s16x4*)vp, hi = *(const LAS s16x4*)(vp + 8);
                    const bf16x8 vf = __builtin_shufflevector(lo, hi, 0, 1, 2, 3, 4, 5, 6, 7);
                    st.o[0][dt] = MFMA32(vf, pf[0][s2], st.o[0][dt]); st.o[1][dt] = MFMA32(vf, pf[1][s2], st.o[1][dt]);
                }
                asm volatile("" ::: "memory");
            }
            if (more) C2_STORE((ti + 1) & 1);
            asm volatile("s_waitcnt vmcnt(0) lgkmcnt(0)" ::: "memory"); __builtin_amdgcn_s_barrier(); asm volatile("" ::: "memory");
        }
#undef C2_LOAD
#undef C2_STORE
        const float l1 = st.l[0] + __shfl_xor(st.l[0], 32), l2 = st.l[1] + __shfl_xor(st.l[1], 32);
        const float r1 = 1.0f / l1, r2 = lam / l2;
        float ss = 0.f;
#pragma unroll
        for (int dt = 0; dt < 4; ++dt)
#pragma unroll
            for (int i = 0; i < 16; ++i) { const float v = st.o[0][dt][i] * r1 - st.o[1][dt][i] * r2; st.o[0][dt][i] = v; ss += v * v; }
        ss += __shfl_xor(ss, 32);
        const float rs = (1.0f / sqrtf(ss * (1.0f / 128.0f) + 1e-5f)) * (1.0f - lam_init);
        bf16* op = O + (size_t)(m0 + q0 + r) * 1024 + head * 128;
#pragma unroll
        for (int dt = 0; dt < 4; ++dt)
#pragma unroll
            for (int g = 0; g < 4; ++g) { const int d = dt * 32 + 8 * g + 4 * h; const f32x4 w = *(const f32x4*)(subln + d);
                *(u32x2*)(op + d) = (u32x2){pk2(st.o[0][dt][4 * g] * rs * w[0], st.o[0][dt][4 * g + 1] * rs * w[1]), pk2(st.o[0][dt][4 * g + 2] * rs * w[2], st.o[0][dt][4 * g + 3] * rs * w[3])}; }
    }
}
__device__ __forceinline__ float shift3(const bf16* p, long pitch, bool hp, bool hn, float mup, float mun) {
    const float c = bf2f(p[0]); const float pv = hp ? bf2f(p[-pitch]) : 0.f; const float nx = hn ? bf2f(p[pitch]) : 0.f;
    return c + mup * (pv - c) + mun * (nx - c);
}
__device__ __forceinline__ float sigmoid_f(float x) { return __builtin_amdgcn_rcpf(1.0f + __builtin_amdgcn_exp2f(-1.4426950408889634f * x)); }
__device__ __forceinline__ float tanh_f(float x) { const float e = __builtin_amdgcn_exp2f(2.8853900817779268f * fminf(fmaxf(x, -15.f), 15.f)); return 1.0f - 2.0f * __builtin_amdgcn_rcpf(e + 1.0f); }
__device__ __forceinline__ void rwkv_scan_phase(Frame& F, int jl) {
    const int it = F.wave * F.G + F.bid;
    if (F.wave >= 3 || it >= 640) return;
    LAS float* vec = (LAS float*)(F.lds + F.wave * 20480);
    LAS float* twl = vec + 6 * 8 * 64;
    LAS float* adl = twl + 8 * 64;
    int b, h, d, T, m0; const bool latent = it < 128;
    if (latent) { b = it >> 4; h = (it >> 1) & 7; d = it & 1; T = TL; m0 = MPR + b * TL; }
    else { const int p = it - 128; b = p >> 4; h = (p >> 1) & 7; d = p & 1; T = TP; m0 = b * TP; }
    const bf16* P = (const bf16*)(F.ws + WS_G);
    bf16* Yd = (bf16*)(F.ws + WS_Y) + (size_t)d * MTOK * 512;
    float* BC = (float*)(F.ws + WS_BC) + (size_t)d * MTOK * 8;
    const int lane = F.lane, col = h * 64 + lane;
    const float* mup = F.in[I_MUP] + jl * 1920; const float* mun = F.in[I_MUN] + jl * 1920;
    const float mp_r = mup[col], mn_r = mun[col], mp_k = mup[512 + col], mn_k = mun[512 + col], mp_v = mup[1024 + col], mn_v = mun[1024 + col];
    const float mp_w = mup[1536 + d * 64 + lane], mn_w = mun[1536 + d * 64 + lane], mp_a = mup[1664 + d * 64 + lane], mn_a = mun[1664 + d * 64 + lane];
    const float w0 = F.in[I_BW0][(jl * 2 + d) * 512 + col], a0 = F.in[I_BA0][(jl * 2 + d) * 512 + col];
    const float kk_c = F.in[I_BKK][jl * 512 + col], ka_c = F.in[I_BKA][jl * 512 + col], rk_c = F.in[I_BRK][jl * 512 + col];
    const float* W2 = F.in[I_BW2] + (size_t)(jl * 2 + d) * 64 * 512 + col; const float* A2 = F.in[I_BA2] + (size_t)(jl * 2 + d) * 64 * 512 + col;
    float S[64];
    if (latent) { const f32x4* sp = (const f32x4*)(F.in[I_SB] + ((size_t)(((b * 2 + jl) * 2 + d) * 8 + h) * 64 + lane) * 64);
#pragma unroll
        for (int j4 = 0; j4 < 16; ++j4) { const f32x4 v = sp[j4]; S[4 * j4] = v.x; S[4 * j4 + 1] = v.y; S[4 * j4 + 2] = v.z; S[4 * j4 + 3] = v.w; } }
    else {
#pragma unroll
        for (int j = 0; j < 64; ++j) S[j] = 0.f; }
    for (int blk = 0; blk < T / 8; ++blk) {
        float r_[8], k_[8], v_[8], kk[8];
#pragma unroll
        for (int tt = 0; tt < 8; ++tt) {
            const int s = blk * 8 + tt, t = d ? T - 1 - s : s; const bool hp = t > 0, hn = t < T - 1;
            const bf16* pr = P + (size_t)(m0 + t) * PLD_AB + 768;
            r_[tt] = shift3(pr + col, PLD_AB, hp, hn, mp_r, mn_r); k_[tt] = shift3(pr + 512 + col, PLD_AB, hp, hn, mp_k, mn_k); v_[tt] = shift3(pr + 1024 + col, PLD_AB, hp, hn, mp_v, mn_v);
            const float wd = shift3(pr + 1536 + d * 64 + lane, PLD_AB, hp, hn, mp_w, mn_w), ad = shift3(pr + 1664 + d * 64 + lane, PLD_AB, hp, hn, mp_a, mn_a);
            twl[tt * 64 + lane] = tanhf(wd); adl[tt * 64 + lane] = ad;
            const float kv = k_[tt] * kk_c; const float nrm = sqrtf(wave_sum(kv * kv)); kk[tt] = kv / fmaxf(nrm, 1e-12f);
        }
        asm volatile("s_waitcnt lgkmcnt(0)" ::: "memory");
        float aw[8], aa[8];
#pragma unroll
        for (int tt = 0; tt < 8; ++tt) { aw[tt] = 0.f; aa[tt] = 0.f; }
        for (int l4 = 0; l4 < 16; ++l4) {
            float wv[4], av[4];
#pragma unroll
            for (int q = 0; q < 4; ++q) { wv[q] = W2[(size_t)(4 * l4 + q) * 512]; av[q] = A2[(size_t)(4 * l4 + q) * 512]; }
#pragma unroll
            for (int tt = 0; tt < 8; ++tt) { const f32x4 t4 = *(const LAS f32x4*)(twl + tt * 64 + 4 * l4), a4 = *(const LAS f32x4*)(adl + tt * 64 + 4 * l4);
                aw[tt] += t4.x * wv[0] + t4.y * wv[1] + t4.z * wv[2] + t4.w * wv[3]; aa[tt] += a4.x * av[0] + a4.y * av[1] + a4.z * av[2] + a4.w * av[3]; }
        }
#pragma unroll
        for (int tt = 0; tt < 8; ++tt) {
            const int s = blk * 8 + tt, t = d ? T - 1 - s : s;
            const float x = -(w0 + aw[tt]); const float sp = fmaxf(x, 0.f) + log1pf(__expf(-fabsf(x)));
            const float wlog = -sp - 0.5f; const float dec = __expf(-__expf(wlog));
            const float a = sigmoid_f(a0 + aa[tt]); const float kd = k_[tt] * (1.0f + (a - 1.0f) * ka_c); const float bb = kk[tt] * a;
            const float bon = wave_sum(r_[tt] * kd * rk_c); if (lane == 0) BC[(size_t)(m0 + t) * 8 + h] = bon;
            vec[(0 * 8 + tt) * 64 + lane] = dec; vec[(1 * 8 + tt) * 64 + lane] = kk[tt]; vec[(2 * 8 + tt) * 64 + lane] = bb;
            vec[(3 * 8 + tt) * 64 + lane] = kd; vec[(4 * 8 + tt) * 64 + lane] = r_[tt]; vec[(5 * 8 + tt) * 64 + lane] = v_[tt];
        }
        asm volatile("s_waitcnt lgkmcnt(0)" ::: "memory");
#pragma unroll 1
        for (int tt = 0; tt < 8; ++tt) {
            const int s = blk * 8 + tt, t = d ? T - 1 - s : s;
            const float vi = vec[(5 * 8 + tt) * 64 + lane];
            float sa = 0.f;
#pragma unroll
            for (int j4 = 0; j4 < 16; ++j4) { const f32x4 k4 = *(const LAS f32x4*)(vec + (1 * 8 + tt) * 64 + 4 * j4);
                sa += S[4 * j4] * k4.x + S[4 * j4 + 1] * k4.y + S[4 * j4 + 2] * k4.z + S[4 * j4 + 3] * k4.w; }
            float y = 0.f;
#pragma unroll
            for (int j4 = 0; j4 < 16; ++j4) {
                const f32x4 w4 = *(const LAS f32x4*)(vec + (0 * 8 + tt) * 64 + 4 * j4), b4 = *(const LAS f32x4*)(vec + (2 * 8 + tt) * 64 + 4 * j4);
                const f32x4 k4 = *(const LAS f32x4*)(vec + (3 * 8 + tt) * 64 + 4 * j4), r4 = *(const LAS f32x4*)(vec + (4 * 8 + tt) * 64 + 4 * j4);
#pragma unroll
                for (int q = 0; q < 4; ++q) { float sv = S[4 * j4 + q]; sv = sv * w4[q] - sa * b4[q] + vi * k4[q]; S[4 * j4 + q] = sv; y += sv * r4[q]; }
            }
            Yd[(size_t)(m0 + t) * 512 + col] = (bf16)f2bf(y);
        }
        asm volatile("s_waitcnt lgkmcnt(0)" ::: "memory");
    }
    if (!latent) { f32x4* op = (f32x4*)(F.out + O_BW + ((size_t)(((b * 2 + jl) * 2 + d) * 8 + h) * 64 + lane) * 64);
#pragma unroll
        for (int j4 = 0; j4 < 16; ++j4) op[j4] = (f32x4){S[4 * j4], S[4 * j4 + 1], S[4 * j4 + 2], S[4 * j4 + 3]}; }
}
__device__ __forceinline__ void rwkv_post_phase(Frame& F, int jl) {
    LAS float* sg = (LAS float*)(F.lds + F.wave * 4096);
    const bf16* P = (const bf16*)(F.ws + WS_G); const bf16* Y0 = (const bf16*)(F.ws + WS_Y); const bf16* Y1 = Y0 + (size_t)MTOK * 512;
    const float* BC = (const float*)(F.ws + WS_BC); bf16* O = (bf16*)(F.ws + WS_H);
    const float* g2 = F.in[I_BG2] + (size_t)jl * 128 * 512; const float* mup = F.in[I_MUP] + jl * 1920; const float* mun = F.in[I_MUN] + jl * 1920;
    const int lane = F.lane, c0 = 8 * lane, head = lane >> 3;
    const int gw = F.bid * 8 + F.wave, NGW = F.G * 8;
    float gnw[8], gnb[8], mpv[8], mnv[8];
#pragma unroll
    for (int i = 0; i < 8; ++i) { gnw[i] = F.in[I_GNW][jl * 512 + c0 + i]; gnb[i] = F.in[I_GNB][jl * 512 + c0 + i]; mpv[i] = mup[1024 + c0 + i]; mnv[i] = mun[1024 + c0 + i]; }
    const float mpg0 = mup[1792 + lane], mng0 = mun[1792 + lane], mpg1 = mup[1856 + lane], mng1 = mun[1856 + lane];
    for (int grp = gw; grp < MTOK / 8; grp += NGW) {
#pragma unroll
        for (int tt = 0; tt < 8; ++tt) { const int m = grp * 8 + tt; const int t = m < MPR ? (m & 255) : ((m - MPR) & 4095); const int T = m < MPR ? TP : TL;
            const bf16* pr = P + (size_t)m * PLD_AB + 768 + 1792;
            sg[tt * 128 + lane] = sigmoid_f(shift3(pr + lane, PLD_AB, t > 0, t < T - 1, mpg0, mng0)); sg[tt * 128 + 64 + lane] = sigmoid_f(shift3(pr + 64 + lane, PLD_AB, t > 0, t < T - 1, mpg1, mng1)); }
        asm volatile("s_waitcnt lgkmcnt(0)" ::: "memory");
        float acc[8][8];
#pragma unroll
        for (int tt = 0; tt < 8; ++tt)
#pragma unroll
            for (int i = 0; i < 8; ++i) acc[tt][i] = 0.f;
#pragma unroll 2
        for (int l4 = 0; l4 < 32; ++l4) {
            f32x4 s4[8];
#pragma unroll
            for (int tt = 0; tt < 8; ++tt) s4[tt] = *(const LAS f32x4*)(sg + tt * 128 + 4 * l4);
#pragma unroll
            for (int q = 0; q < 4; ++q) { const f32x4 ga = *(const f32x4*)(g2 + (size_t)(4 * l4 + q) * 512 + c0), gb = *(const f32x4*)(g2 + (size_t)(4 * l4 + q) * 512 + c0 + 4);
#pragma unroll
                for (int tt = 0; tt < 8; ++tt) { const float s = s4[tt][q];
#pragma unroll
                    for (int i = 0; i < 4; ++i) { acc[tt][i] += s * ga[i]; acc[tt][4 + i] += s * gb[i]; } } }
        }
#pragma unroll
        for (int tt = 0; tt < 8; ++tt) { const int m = grp * 8 + tt; const int t = m < MPR ? (m & 255) : ((m - MPR) & 4095); const int T = m < MPR ? TP : TL;
            const bf16x8 ya = *(const bf16x8*)(Y0 + (size_t)m * 512 + c0), yb = *(const bf16x8*)(Y1 + (size_t)m * 512 + c0);
            float y[8]; float sm = 0.f;
#pragma unroll
            for (int i = 0; i < 8; ++i) { y[i] = bf2f((unsigned short)ya[i]) + bf2f((unsigned short)yb[i]); sm += y[i]; }
            sm += __shfl_xor(sm, 1); sm += __shfl_xor(sm, 2); sm += __shfl_xor(sm, 4);
            const float mu = sm * (1.0f / 64.0f); float vs = 0.f;
#pragma unroll
            for (int i = 0; i < 8; ++i) { y[i] -= mu; vs += y[i] * y[i]; }
            vs += __shfl_xor(vs, 1); vs += __shfl_xor(vs, 2); vs += __shfl_xor(vs, 4);
            const float rs = 1.0f / sqrtf(vs * (1.0f / 64.0f) + 64e-5f);
            const bf16* pv = P + (size_t)m * PLD_AB + 768 + 1024 + c0;
            const bf16x8 vc = *(const bf16x8*)pv; bf16x8 vp = vc, vn = vc;
            const bool hp = t > 0, hn = t < T - 1;
            if (hp) vp = *(const bf16x8*)(pv - PLD_AB); if (hn) vn = *(const bf16x8*)(pv + PLD_AB);
            const float bon = BC[(size_t)m * 8 + head] + BC[((size_t)MTOK + m) * 8 + head];
            float o[8];
#pragma unroll
            for (int i = 0; i < 8; ++i) { const float c = bf2f((unsigned short)vc[i]); const float pvv = hp ? bf2f((unsigned short)vp[i]) : 0.f, nvv = hn ? bf2f((unsigned short)vn[i]) : 0.f;
                const float v = c + mpv[i] * (pvv - c) + mnv[i] * (nvv - c);
                o[i] = (y[i] * rs * gnw[i] + gnb[i] + bon * v) * acc[tt][i]; }
            *(u32x4*)(O + (size_t)m * 1024 + 512 + c0) = (u32x4){pk2(o[0], o[1]), pk2(o[2], o[3]), pk2(o[4], o[5]), pk2(o[6], o[7])};
        }
        asm volatile("s_waitcnt lgkmcnt(0)" ::: "memory");
    }
}
constexpr int PT = 72;
constexpr int SLOT = 64 * PT * 2;
constexpr int F32P = 68;
__device__ __forceinline__ LAS bf16* slot(Frame& F, int k) { return (LAS bf16*)(F.lds + k * SLOT); }
__device__ __forceinline__ void mm64(f32x16 (&acc)[2][2], const LAS bf16* A, const LAS bf16* B, int lane) {
    const int r = lane & 31, h = lane >> 5;
#pragma unroll
    for (int ks = 0; ks < 4; ++ks) {
        bf16x8 af[2], bfr[2];
#pragma unroll
        for (int t = 0; t < 2; ++t) { af[t] = *(const LAS bf16x8*)(A + (32 * t + r) * PT + 16 * ks + 8 * h); bfr[t] = *(const LAS bf16x8*)(B + (32 * t + r) * PT + 16 * ks + 8 * h); }
#pragma unroll
        for (int rt = 0; rt < 2; ++rt)
#pragma unroll
            for (int ct = 0; ct < 2; ++ct) acc[rt][ct] = MFMA32(af[rt], bfr[ct], acc[rt][ct]);
    }
}
__device__ __forceinline__ void mm64_gB(f32x16 (&acc)[2][2], const LAS bf16* A, const bf16* Bg, int lane) {
    const int r = lane & 31, h = lane >> 5;
#pragma unroll
    for (int ks = 0; ks < 4; ++ks) {
        bf16x8 af[2], bfr[2];
#pragma unroll
        for (int t = 0; t < 2; ++t) { af[t] = *(const LAS bf16x8*)(A + (32 * t + r) * PT + 16 * ks + 8 * h); bfr[t] = *(const bf16x8*)(Bg + (32 * t + r) * 64 + 16 * ks + 8 * h); }
#pragma unroll
        for (int rt = 0; rt < 2; ++rt)
#pragma unroll
            for (int ct = 0; ct < 2; ++ct) acc[rt][ct] = MFMA32(af[rt], bfr[ct], acc[rt][ct]);
    }
}
__device__ __forceinline__ void zero_acc(f32x16 (&acc)[2][2]) {
#pragma unroll
    for (int a = 0; a < 2; ++a)
#pragma unroll
        for (int b = 0; b < 2; ++b)
#pragma unroll
            for (int i = 0; i < 16; ++i) acc[a][b][i] = 0.f;
}
template <int MASK> __device__ __forceinline__ void store_nat_bf16(const f32x16 (&acc)[2][2], LAS bf16* D, int lane) {
    const int r = lane & 31, h = lane >> 5;
#pragma unroll
    for (int rt = 0; rt < 2; ++rt)
#pragma unroll
        for (int ct = 0; ct < 2; ++ct)
#pragma unroll
            for (int i = 0; i < 16; i += 2) { const int row = 32 * rt + crow(i, h), col = 32 * ct + r; float v0 = acc[rt][ct][i], v1 = acc[rt][ct][i + 1];
                if (MASK && rt < ct) { v0 = 0.f; v1 = 0.f; }
                if (MASK == 1 && rt == ct) { v0 *= (float)((unsigned)(col - row) >> 31); v1 *= (float)((unsigned)(col - row - 1) >> 31); }
                if (MASK == 2 && rt == ct) { v0 *= (float)((unsigned)(col - row - 1) >> 31); v1 *= (float)((unsigned)(col - row - 2) >> 31); }
                const unsigned w = pk2(v0, v1);
                D[row * PT + col] = (bf16)(w & 0xffffu); D[(row + 1) * PT + col] = (bf16)(w >> 16); }
}
template <int MASK> __device__ __forceinline__ void store_nat_f32(const f32x16 (&acc)[2][2], LAS float* D, int lane) {
    const int r = lane & 31, h = lane >> 5;
#pragma unroll
    for (int rt = 0; rt < 2; ++rt)
#pragma unroll
        for (int ct = 0; ct < 2; ++ct)
#pragma unroll
            for (int i = 0; i < 16; ++i) { const int row = 32 * rt + crow(i, h), col = 32 * ct + r; float v = acc[rt][ct][i];
                if (MASK == 1 && rt < ct) v = 0.f;
                if (MASK == 1 && rt == ct) v *= (float)((unsigned)(col - row) >> 31);
                D[row * F32P + col] = v; }
}
__device__ __forceinline__ void store_tr_g(const f32x16 (&acc)[2][2], bf16* D, long pitch, int lane) {
    const int r = lane & 31, h = lane >> 5;
#pragma unroll
    for (int rt = 0; rt < 2; ++rt)
#pragma unroll
        for (int ct = 0; ct < 2; ++ct)
#pragma unroll
            for (int g = 0; g < 4; ++g) { const int row = 32 * rt + 8 * g + 4 * h, col = 32 * ct + r;
                *(u32x2*)(D + (long)col * pitch + row) = (u32x2){pk2(acc[rt][ct][4 * g], acc[rt][ct][4 * g + 1]), pk2(acc[rt][ct][4 * g + 2], acc[rt][ct][4 * g + 3])}; }
}
__device__ __forceinline__ void load8(float (&o)[8], const bf16* p) { const bf16x8 v = *(const bf16x8*)p;
#pragma unroll
    for (int i = 0; i < 8; ++i) o[i] = bf2f((unsigned short)v[i]); }
__device__ __forceinline__ void shift8(float (&o)[8], const bf16* p, bool hp, bool hn, const float* mup, const float* mun) {
    float c[8], a[8], b[8]; load8(c, p);
    if (hp) load8(a, p - PLD_AB); if (hn) load8(b, p + PLD_AB);
#pragma unroll
    for (int i = 0; i < 8; ++i) { const float pv = hp ? a[i] : 0.f, nx = hn ? b[i] : 0.f; o[i] = c[i] + mup[i] * (pv - c[i]) + mun[i] * (nx - c[i]); }
}
__device__ __forceinline__ void solve_col(const LAS float* A, const LAS bf16* rhs, LAS bf16* dst, int lane) {
    float x[64];
    { int z = 0; asm volatile("" : "+v"(z)); A += z; }
#pragma unroll
    for (int t = 0; t < 64; ++t) x[t] = bf2f(rhs[t * PT + lane]);
    asm volatile("s_waitcnt lgkmcnt(0)" ::: "memory");
    x[1] -= A[1 * F32P + 0] * x[0];
#pragma unroll
    for (int t = 2; t < 64; t += 2) {
        float s0 = 0.f, s1 = 0.f, r0 = 0.f, r1 = 0.f;
#pragma unroll
        for (int u4 = 0; u4 < t / 4 + 1; ++u4) { if (4 * u4 < t) { const f32x4 a = *(const LAS f32x4*)(A + t * F32P + 4 * u4), b = *(const LAS f32x4*)(A + (t + 1) * F32P + 4 * u4);
            if (4 * u4 + 0 < t) { s0 += a[0] * x[4 * u4 + 0]; r0 += b[0] * x[4 * u4 + 0]; } if (4 * u4 + 1 < t) { s1 += a[1] * x[4 * u4 + 1]; r1 += b[1] * x[4 * u4 + 1]; }
            if (4 * u4 + 2 < t) { s0 += a[2] * x[4 * u4 + 2]; r0 += b[2] * x[4 * u4 + 2]; } if (4 * u4 + 3 < t) { s1 += a[3] * x[4 * u4 + 3]; r1 += b[3] * x[4 * u4 + 3]; } } }
        x[t] -= s0 + s1;
        x[t + 1] -= (r0 + r1) + A[(t + 1) * F32P + t] * x[t];
        asm volatile("" : "+v"(x[t]), "+v"(x[t + 1]));
    }
    asm volatile("s_waitcnt lgkmcnt(0)" ::: "memory");
#pragma unroll
    for (int q = 0; q < 8; ++q)
        *(LAS u32x4*)(dst + lane * PT + 8 * q) = (u32x4){pk2(x[8 * q], x[8 * q + 1]), pk2(x[8 * q + 2], x[8 * q + 3]), pk2(x[8 * q + 4], x[8 * q + 5]), pk2(x[8 * q + 6], x[8 * q + 7])};
    asm volatile("s_waitcnt lgkmcnt(0)" ::: "memory");
}
constexpr size_t WS_LORA = 7 * MiB;
constexpr size_t WS_R = WS_END;
constexpr size_t WS_END2 = WS_R + 80 * MiB;
__device__ __forceinline__ int r_item(bool latent, int b, int h, int c) { return latent ? ((b * 8 + h) * 64 + c) : (4096 + (b * 8 + h) * 4 + c); }

__device__ __forceinline__ void shift8c(float (&o)[8], const bf16x8& rc, const bf16* p, bool hp, bool hn, const float* mup, const float* mun) {
    float a[8], b[8];
    if (hp) load8(a, p - PLD_AB); if (hn) load8(b, p + PLD_AB);
#pragma unroll
    for (int i = 0; i < 8; ++i) { const float c = bf2f((unsigned short)rc[i]); const float pv = hp ? a[i] : 0.f, nx = hn ? b[i] : 0.f; o[i] = c + mup[i] * (pv - c) + mun[i] * (nx - c); }
}
__device__ __forceinline__ void bar_all() { asm volatile("s_waitcnt vmcnt(0) lgkmcnt(0)" ::: "memory"); __builtin_amdgcn_s_barrier(); asm volatile("" ::: "memory"); }
__device__ __forceinline__ void rwkv_r1(Frame& F, int jl, int d) {
    LAS bf16* S0 = slot(F, 0); LAS bf16* S1 = slot(F, 1); LAS bf16* S2 = slot(F, 2); LAS bf16* S3 = slot(F, 3); LAS bf16* S4 = slot(F, 4);
    LAS bf16* S5 = slot(F, 5); LAS bf16* S6 = slot(F, 6); LAS bf16* S7 = slot(F, 7); LAS bf16* S8 = slot(F, 8);
    LAS bf16* S9 = slot(F, 9); LAS bf16* S10 = slot(F, 10); LAS bf16* S11 = slot(F, 11);
    LAS float* F32 = (LAS float*)(F.lds + 12 * SLOT); LAS float* PCv = F32 + 64 * F32P; LAS float* KN = PCv + 64; LAS float* BN = KN + 512;
    const bf16* P = (const bf16*)(F.ws + WS_G);
    bf16* Yd = (bf16*)(F.ws + WS_Y) + (size_t)d * MTOK * 512; bf16* Ob = (bf16*)(F.ws + WS_H);
    float* BC = (float*)(F.ws + WS_BC) + (size_t)d * MTOK * 8;
    const float* mup_u = F.in[I_MUP] + jl * 1920; const float* mun_u = F.in[I_MUN] + jl * 1920;
    const int w = F.wave;
    bf16x8 rawc[5];
#define R1_LOADRAW(IT, LANE) do { int b_, h_, c_, T_, m0_; if ((IT) < 4096) { b_ = (IT) >> 9; h_ = ((IT) >> 6) & 7; c_ = (IT) & 63; T_ = TL; m0_ = MPR + b_ * TL; } \
        else { const int p_ = (IT) - 4096; b_ = p_ >> 5; h_ = (p_ >> 2) & 7; c_ = p_ & 3; T_ = TP; m0_ = b_ * TP; } \
        const int tok_ = d ? T_ - 1 - (64 * c_ + (LANE)) : 64 * c_ + (LANE); const bf16* pr_ = P + (size_t)(m0_ + tok_) * PLD_AB + 768 + 8 * w; const int hc_ = h_ * 64; \
        rawc[0] = *(const bf16x8*)(pr_ + hc_); rawc[1] = *(const bf16x8*)(pr_ + 1024 + hc_); rawc[2] = *(const bf16x8*)(pr_ + 1536 + d * 64); rawc[3] = *(const bf16x8*)(pr_ + 1664 + d * 64); rawc[4] = *(const bf16x8*)(pr_ + 512 + hc_); } while (0)
    if (F.bid < 5120) R1_LOADRAW(F.bid, F.lane);
    for (int it = F.bid; it < 5120; it += F.G) {
        int lane = F.lane; asm volatile("" : "+v"(lane));
        int zv = 0; asm volatile("" : "+v"(zv));
        const float* mup = mup_u + zv; const float* mun = mun_u + zv;
        const float* pKK = F.in[I_BKK] + jl * 512 + zv; const float* pKA = F.in[I_BKA] + jl * 512 + zv; const float* pRK = F.in[I_BRK] + jl * 512 + zv; const float* pA0 = F.in[I_BA0] + (jl * 2 + d) * 512 + zv;
        int b, h, c, T, m0; const bool latent = it < 4096;
        if (latent) { b = it >> 9; h = (it >> 6) & 7; c = it & 63; T = TL; m0 = MPR + b * TL; }
        else { const int p = it - 4096; b = p >> 5; h = (p >> 2) & 7; c = p & 3; T = TP; m0 = b * TP; }
        const int tok = d ? T - 1 - (64 * c + lane) : 64 * c + lane;
        const bool hp = tok > 0, hn = tok < T - 1;
        const bf16* prow = P + (size_t)(m0 + tok) * PLD_AB + 768;
        const int hc = h * 64, q = w;
        const int r = lane & 31, hh = lane >> 5;
        float k8[8], r8[8], v8[8];
        shift8c(r8, rawc[0], prow + hc + 8 * q, hp, hn, mup + hc + 8 * q, mun + hc + 8 * q);
        shift8c(v8, rawc[1], prow + 1024 + hc + 8 * q, hp, hn, mup + 1024 + hc + 8 * q, mun + 1024 + hc + 8 * q);
        { float x[8];
          shift8c(x, rawc[2], prow + 1536 + d * 64 + 8 * q, hp, hn, mup + 1536 + d * 64 + 8 * q, mun + 1536 + d * 64 + 8 * q);
          *(LAS u32x4*)(S0 + lane * PT + 8 * q) = (u32x4){pk2(tanh_f(x[0]), tanh_f(x[1])), pk2(tanh_f(x[2]), tanh_f(x[3])), pk2(tanh_f(x[4]), tanh_f(x[5])), pk2(tanh_f(x[6]), tanh_f(x[7]))};
          shift8c(x, rawc[3], prow + 1664 + d * 64 + 8 * q, hp, hn, mup + 1664 + d * 64 + 8 * q, mun + 1664 + d * 64 + 8 * q);
          *(LAS u32x4*)(S1 + lane * PT + 8 * q) = (u32x4){pk2(x[0], x[1]), pk2(x[2], x[3]), pk2(x[4], x[5]), pk2(x[6], x[7])};
          shift8c(k8, rawc[4], prow + 512 + hc + 8 * q, hp, hn, mup + 512 + hc + 8 * q, mun + 512 + hc + 8 * q);
          float ss = 0.f;
#pragma unroll
          for (int i = 0; i < 8; ++i) { const float kv = k8[i] * pKK[hc + 8 * q + i]; ss += kv * kv; }
          KN[q * 64 + lane] = ss; }
        bar_all();
        if (w == 0) { f32x16 acc[2][2]; zero_acc(acc); mm64_gB(acc, S0, (const bf16*)(F.ws + WS_LORA) + ((size_t)(jl * 2 + d) * 512 + hc) * 64, lane); store_nat_f32<0>(acc, F32, lane); }
        else if (w == 1) { f32x16 acc[2][2]; zero_acc(acc); mm64_gB(acc, S1, (const bf16*)(F.ws + WS_LORA) + ((size_t)(4 + jl * 2 + d) * 512 + hc) * 64, lane); store_nat_bf16<0>(acc, S2, lane); }
        bar_all();
        { const float w0 = F.in[I_BW0][(jl * 2 + d) * 512 + hc + lane];
#pragma unroll
          for (int tt = 0; tt < 8; ++tt) { const int t = 8 * w + tt; const float x = -(w0 + F32[t * F32P + lane]); const float sp = fmaxf(x, 0.f) + 0.6931471805599453f * __builtin_amdgcn_logf(1.0f + __builtin_amdgcn_exp2f(-1.4426950408889634f * fabsf(x)));
              F32[t * F32P + lane] = -__expf(-sp - 0.5f); } }
        bar_all();
        if (w == 0) { float cum = 0.f;
#pragma unroll 16
          for (int t = 0; t < 64; ++t) { cum += F32[t * F32P + lane]; F32[t * F32P + lane] = cum; }
          PCv[lane] = cum; }
        bar_all();
        { float ss = 0.f;
#pragma unroll
          for (int u = 0; u < 8; ++u) ss += KN[u * 64 + lane];
          const float knorm = 1.0f / fmaxf(sqrtf(ss), 1e-12f);
          float al[8], lp[8], lpm[8];
          { const bf16x8 av = *(const LAS bf16x8*)(S2 + lane * PT + 8 * q);
#pragma unroll
            for (int i = 0; i < 8; ++i) al[i] = bf2f((unsigned short)av[i]); }
          { const f32x4 a = *(const LAS f32x4*)(F32 + lane * F32P + 8 * q), b4 = *(const LAS f32x4*)(F32 + lane * F32P + 8 * q + 4);
            lp[0] = a[0]; lp[1] = a[1]; lp[2] = a[2]; lp[3] = a[3]; lp[4] = b4[0]; lp[5] = b4[1]; lp[6] = b4[2]; lp[7] = b4[3];
            if (lane > 0) { const f32x4 c4 = *(const LAS f32x4*)(F32 + (lane - 1) * F32P + 8 * q), d4 = *(const LAS f32x4*)(F32 + (lane - 1) * F32P + 8 * q + 4);
                lpm[0] = c4[0]; lpm[1] = c4[1]; lpm[2] = c4[2]; lpm[3] = c4[3]; lpm[4] = d4[0]; lpm[5] = d4[1]; lpm[6] = d4[2]; lpm[7] = d4[3]; }
            else {
#pragma unroll
                for (int i = 0; i < 8; ++i) lpm[i] = 0.f; } }
          float kkh[8], bt[8], kt[8], rh[8]; float bonus = 0.f;
#pragma unroll
          for (int i = 0; i < 8; ++i) { const int j = hc + 8 * q + i;
              const float a = sigmoid_f(pA0[j] + al[i]);
              const float kk = k8[i] * pKK[j] * knorm;
              const float kd = k8[i] * (1.0f + (a - 1.0f) * pKA[j]);
              const float bb = kk * a;
              bonus += r8[i] * kd * pRK[j];
              const float ip = __expf(-lp[i]), pcp = __expf(PCv[8 * q + i] - lp[i]);
              kkh[i] = kk * __expf(lpm[i]); bt[i] = bb * ip; kt[i] = kd * ip; rh[i] = r8[i] * __expf(lp[i]);
              S5[(8 * q + i) * PT + lane] = (bf16)f2bf(bb * pcp); S6[(8 * q + i) * PT + lane] = (bf16)f2bf(kd * pcp); S7[(8 * q + i) * PT + lane] = (bf16)f2bf(v8[i]); }
          *(LAS u32x4*)(S0 + lane * PT + 8 * q) = (u32x4){pk2(kkh[0], kkh[1]), pk2(kkh[2], kkh[3]), pk2(kkh[4], kkh[5]), pk2(kkh[6], kkh[7])};
          *(LAS u32x4*)(S1 + lane * PT + 8 * q) = (u32x4){pk2(bt[0], bt[1]), pk2(bt[2], bt[3]), pk2(bt[4], bt[5]), pk2(bt[6], bt[7])};
          *(LAS u32x4*)(S3 + lane * PT + 8 * q) = (u32x4){pk2(kt[0], kt[1]), pk2(kt[2], kt[3]), pk2(kt[4], kt[5]), pk2(kt[6], kt[7])};
          *(LAS u32x4*)(S4 + lane * PT + 8 * q) = (u32x4){pk2(rh[0], rh[1]), pk2(rh[2], rh[3]), pk2(rh[4], rh[5]), pk2(rh[6], rh[7])};
          BN[q * 64 + lane] = bonus; }
        bar_all();
        if (w == 0) { f32x16 acc[2][2]; zero_acc(acc); mm64(acc, S0, S1, lane); store_nat_f32<1>(acc, F32, lane); }
        else if (w == 1) { f32x16 acc[2][2]; zero_acc(acc); mm64(acc, S0, S3, lane); store_nat_bf16<1>(acc, S2, lane);
            asm volatile("s_waitcnt lgkmcnt(0)" ::: "memory");
            zero_acc(acc); mm64(acc, S2, S7, lane); store_nat_bf16<0>(acc, S8, lane); }
        else if (w == 2) { f32x16 acc[2][2]; zero_acc(acc); mm64(acc, S4, S1, lane); store_nat_bf16<2>(acc, S9, lane); }
        else if (w == 3) { f32x16 acc[2][2]; zero_acc(acc); mm64(acc, S4, S3, lane); store_nat_bf16<2>(acc, S10, lane); }
        else if (w == 4) { float bs = 0.f;
#pragma unroll
            for (int u = 0; u < 8; ++u) bs += BN[u * 64 + lane];
            BC[(size_t)(m0 + tok) * 8 + h] = bs; }
        bar_all();
        if (w == 0) solve_col(F32, S0, S0, lane);
        else if (w == 1) solve_col(F32, S8, S11, lane);
        bar_all();
        if (it + F.G < 5120) R1_LOADRAW(it + F.G, lane);
        bf16* RM = (bf16*)(F.ws + WS_R) + (size_t)it * 8192;
        if (w == 0) { f32x16 acc[2][2]; zero_acc(acc); mm64(acc, S0, S5, lane);
          float pcc[2]; pcc[0] = __expf(PCv[r]); pcc[1] = __expf(PCv[32 + r]);
#pragma unroll
          for (int rt = 0; rt < 2; ++rt)
#pragma unroll
              for (int ct = 0; ct < 2; ++ct)
#pragma unroll
                  for (int i = 0; i < 16; ++i) { const int row = 32 * rt + crow(i, hh), col = 32 * ct + r; acc[rt][ct][i] = (row == col ? pcc[ct] : 0.f) - acc[rt][ct][i]; }
#pragma unroll
          for (int jq = 0; jq < 2; ++jq)
#pragma unroll
              for (int jt = 0; jt < 2; ++jt)
#pragma unroll
                  for (int s2 = 0; s2 < 2; ++s2) *(bf16x8*)(RM + ((jq * 2 + jt) * 2 + s2) * 512 + lane * 8) = pack8(acc[jt][jq], s2); }
        else if (w == 1) { f32x16 a1[2][2]; zero_acc(a1); mm64(a1, S5, S11, lane);
#pragma unroll
          for (int rt = 0; rt < 2; ++rt)
#pragma unroll
              for (int ct = 0; ct < 2; ++ct) a1[rt][ct] = -a1[rt][ct];
          mm64(a1, S6, S7, lane);
#pragma unroll
          for (int jq = 0; jq < 2; ++jq)
#pragma unroll
              for (int it2 = 0; it2 < 2; ++it2)
#pragma unroll
                  for (int s2 = 0; s2 < 2; ++s2) *(bf16x8*)(RM + 4096 + ((jq * 2 + it2) * 2 + s2) * 512 + lane * 8) = pack8(a1[jq][it2], s2); }
        else if (w == 2) { f32x16 a1[2][2]; zero_acc(a1); mm64(a1, S0, S9, lane);
#pragma unroll
          for (int jt = 0; jt < 2; ++jt)
#pragma unroll
              for (int ct = 0; ct < 2; ++ct) { const int t = 32 * ct + r; const int tk = d ? T - 1 - (64 * c + t) : 64 * c + t;
#pragma unroll
                  for (int s2 = 0; s2 < 2; ++s2) { const int j0 = 32 * jt + 16 * s2 + 4 * hh;
                      const s16x4 ra = *(const LAS s16x4*)(S4 + t * PT + j0), rb = *(const LAS s16x4*)(S4 + t * PT + j0 + 8);
                      u32x4 wv; wv.x = pk2(bf2f((unsigned short)ra[0]) - a1[jt][ct][8 * s2], bf2f((unsigned short)ra[1]) - a1[jt][ct][8 * s2 + 1]); wv.y = pk2(bf2f((unsigned short)ra[2]) - a1[jt][ct][8 * s2 + 2], bf2f((unsigned short)ra[3]) - a1[jt][ct][8 * s2 + 3]);
                      wv.z = pk2(bf2f((unsigned short)rb[0]) - a1[jt][ct][8 * s2 + 4], bf2f((unsigned short)rb[1]) - a1[jt][ct][8 * s2 + 5]); wv.w = pk2(bf2f((unsigned short)rb[2]) - a1[jt][ct][8 * s2 + 6], bf2f((unsigned short)rb[3]) - a1[jt][ct][8 * s2 + 7]);
                      *(u32x4*)(Ob + (size_t)(m0 + tk) * 1024 + 512 + hc + ((jt * 2 + s2) * 2 + hh) * 8) = wv; } } }
        else if (w == 3) { f32x16 a1[2][2]; zero_acc(a1); mm64(a1, S11, S9, lane);
#pragma unroll
          for (int rt = 0; rt < 2; ++rt)
#pragma unroll
              for (int ct = 0; ct < 2; ++ct) a1[rt][ct] = -a1[rt][ct];
          mm64(a1, S7, S10, lane);
#pragma unroll
          for (int rt = 0; rt < 2; ++rt)
#pragma unroll
              for (int ct = 0; ct < 2; ++ct)
#pragma unroll
                  for (int g = 0; g < 4; ++g) { const int i0 = 32 * rt + 8 * g + 4 * hh, t = 32 * ct + r; const int tk = d ? T - 1 - (64 * c + t) : 64 * c + t;
                      *(u32x2*)(Yd + (size_t)(m0 + tk) * 512 + hc + i0) = (u32x2){pk2(a1[rt][ct][4 * g], a1[rt][ct][4 * g + 1]), pk2(a1[rt][ct][4 * g + 2], a1[rt][ct][4 * g + 3])}; } }
        bar_all();
    }
#undef R1_LOADRAW
}

__device__ __forceinline__ bf16x8 ld_perm(const bf16* p) {
    const s16x4 lo = *(const s16x4*)p, hi = *(const s16x4*)(p + 8); return __builtin_shufflevector(lo, hi, 0, 1, 2, 3, 4, 5, 6, 7);
}
__device__ __forceinline__ void rwkv_r2a(Frame& F, int jl, int d) {
    const int sc = F.wave * F.G + F.bid;
    if (F.wave >= 2 || sc >= 320) return;
    const int lane = F.lane, r = lane & 31, hh = lane >> 5;
    int b, h, T; const bool latent = sc < 64;
    if (latent) { b = sc >> 3; h = sc & 7; T = TL; } else { const int p = sc - 64; b = p >> 3; h = p & 7; T = TP; }
    f32x16 S[2][2];
    if (latent) { const float* sp = F.in[I_SB] + (size_t)(((b * 2 + jl) * 2 + d) * 8 + h) * 4096;
#pragma unroll
        for (int jt = 0; jt < 2; ++jt)
#pragma unroll
            for (int it = 0; it < 2; ++it)
#pragma unroll
                for (int g = 0; g < 4; ++g) { const f32x4 v = *(const f32x4*)(sp + (32 * it + r) * 64 + 32 * jt + 8 * g + 4 * hh);
                    S[jt][it][4 * g] = v[0]; S[jt][it][4 * g + 1] = v[1]; S[jt][it][4 * g + 2] = v[2]; S[jt][it][4 * g + 3] = v[3]; } }
    else zero_acc(S);
    const int NC = T / 64;
    LAS unsigned char* ring = F.lds + F.wave * 65536;
    constexpr int DEPTH = 3;
#define R2_DMA(CI) do { const bf16* RM_ = (const bf16*)(F.ws + WS_R) + (size_t)r_item(latent, b, h, (CI)) * 8192 + lane * 8; \
        LAS unsigned char* dst_ = ring + ((CI) & 3) * 16384; \
        _Pragma("unroll") for (int f_ = 0; f_ < 16; ++f_) __builtin_amdgcn_global_load_lds((const unsigned*)(RM_ + f_ * 512), (LAS unsigned*)(dst_ + f_ * 1024), 16, 0, 0); } while (0)
    for (int c0 = 0; c0 < DEPTH && c0 < NC; ++c0) R2_DMA(c0);
    for (int c = 0; c < NC; ++c) {
        bf16* RMc = (bf16*)(F.ws + WS_R) + (size_t)r_item(latent, b, h, c) * 8192 + lane * 8;
        const int rem = NC - 1 - c;
        const int allow = 16 * (rem < 2 ? rem : 2) + 8 * (c < 2 ? c : 2);
        if (allow >= 48) asm volatile("s_waitcnt vmcnt(48)" ::: "memory"); else if (allow >= 40) asm volatile("s_waitcnt vmcnt(40)" ::: "memory");
        else if (allow >= 32) asm volatile("s_waitcnt vmcnt(32)" ::: "memory"); else if (allow >= 24) asm volatile("s_waitcnt vmcnt(24)" ::: "memory");
        else if (allow >= 16) asm volatile("s_waitcnt vmcnt(16)" ::: "memory"); else if (allow >= 8) asm volatile("s_waitcnt vmcnt(8)" ::: "memory");
        else asm volatile("s_waitcnt vmcnt(0)" ::: "memory");
        const LAS bf16x8* fr = (const LAS bf16x8*)(ring + (c & 3) * 16384) + lane;
        bf16x8 Mc[2][2][2], Nc[2][2][2];
#pragma unroll
        for (int a_ = 0; a_ < 2; ++a_)
#pragma unroll
            for (int b_ = 0; b_ < 2; ++b_)
#pragma unroll
                for (int s2 = 0; s2 < 2; ++s2) { Mc[a_][b_][s2] = fr[((a_ * 2 + b_) * 2 + s2) * 64]; Nc[a_][b_][s2] = fr[(8 + (a_ * 2 + b_) * 2 + s2) * 64]; }
        asm volatile("s_waitcnt lgkmcnt(0)" ::: "memory");
        bf16x8 Sb[2][2][2];
#pragma unroll
        for (int jt = 0; jt < 2; ++jt)
#pragma unroll
            for (int s2 = 0; s2 < 2; ++s2)
#pragma unroll
                for (int it = 0; it < 2; ++it) { Sb[jt][s2][it] = pack8(S[jt][it], s2); *(bf16x8*)(RMc + ((jt * 2 + s2) * 2 + it) * 512) = Sb[jt][s2][it]; }
        if (c + DEPTH < NC) R2_DMA(c + DEPTH);
        f32x16 Sn[2][2];
#pragma unroll
        for (int jq = 0; jq < 2; ++jq)
#pragma unroll
            for (int it = 0; it < 2; ++it)
#pragma unroll
                for (int s2 = 0; s2 < 2; ++s2)
#pragma unroll
                    for (int jj = 0; jj < 8; ++jj) Sn[jq][it][8 * s2 + jj] = bf2f((unsigned short)Nc[jq][it][s2][jj]);
#pragma unroll
        for (int jq = 0; jq < 2; ++jq)
#pragma unroll
            for (int jt = 0; jt < 2; ++jt)
#pragma unroll
                for (int s2 = 0; s2 < 2; ++s2)
#pragma unroll
                    for (int it = 0; it < 2; ++it) Sn[jq][it] = MFMA32(Mc[jq][jt][s2], Sb[jt][s2][it], Sn[jq][it]);
#pragma unroll
        for (int jq = 0; jq < 2; ++jq)
#pragma unroll
            for (int it = 0; it < 2; ++it) S[jq][it] = Sn[jq][it];
    }
    asm volatile("s_waitcnt vmcnt(0)" ::: "memory");
#define R2_LOAD(x)
#undef R2_LOAD
    if (!latent) { float* op = F.out + O_BW + (size_t)(((b * 2 + jl) * 2 + d) * 8 + h) * 4096;
#pragma unroll
        for (int jt = 0; jt < 2; ++jt)
#pragma unroll
            for (int it = 0; it < 2; ++it)
#pragma unroll
                for (int g = 0; g < 4; ++g) *(f32x4*)(op + (32 * it + r) * 64 + 32 * jt + 8 * g + 4 * hh) = (f32x4){S[jt][it][4 * g], S[jt][it][4 * g + 1], S[jt][it][4 * g + 2], S[jt][it][4 * g + 3]}; }
}
__device__ __forceinline__ void rwkv_r2b(Frame& F, int jl, int d) {
    const int lane = F.lane, r = lane & 31, hh = lane >> 5;
    bf16* Yd = (bf16*)(F.ws + WS_Y) + (size_t)d * MTOK * 512; const bf16* Ob = (const bf16*)(F.ws + WS_H);
    for (int it = F.bid * 8 + F.wave; it < 5120; it += F.G * 8) {
        int b, h, c, T, m0; const bool latent = it < 4096;
        if (latent) { b = it >> 9; h = (it >> 6) & 7; c = it & 63; T = TL; m0 = MPR + b * TL; }
        else { const int p = it - 4096; b = p >> 5; h = (p >> 2) & 7; c = p & 3; T = TP; m0 = b * TP; }
        const int hc = h * 64;
        const bf16* RM = (const bf16*)(F.ws + WS_R) + (size_t)it * 8192 + lane * 8;
        bf16x8 Sb[2][2][2];
#pragma unroll
        for (int jt = 0; jt < 2; ++jt)
#pragma unroll
            for (int s2 = 0; s2 < 2; ++s2)
#pragma unroll
                for (int i2 = 0; i2 < 2; ++i2) Sb[jt][s2][i2] = *(const bf16x8*)(RM + ((jt * 2 + s2) * 2 + i2) * 512);
#pragma unroll
        for (int tt = 0; tt < 2; ++tt) {
            const int t = 32 * tt + r; const int tk = d ? T - 1 - (64 * c + t) : 64 * c + t;
            const bf16* qp = Ob + (size_t)(m0 + tk) * 1024 + 512 + hc + 8 * hh; bf16* yp = Yd + (size_t)(m0 + tk) * 512 + hc + 4 * hh;
            f32x16 y[2];
#pragma unroll
            for (int i2 = 0; i2 < 2; ++i2)
#pragma unroll
                for (int g = 0; g < 4; ++g) { const s16x4 z = *(const s16x4*)(yp + 32 * i2 + 8 * g);
                    y[i2][4 * g] = bf2f((unsigned short)z[0]); y[i2][4 * g + 1] = bf2f((unsigned short)z[1]); y[i2][4 * g + 2] = bf2f((unsigned short)z[2]); y[i2][4 * g + 3] = bf2f((unsigned short)z[3]); }
#pragma unroll
            for (int jt = 0; jt < 2; ++jt)
#pragma unroll
                for (int s2 = 0; s2 < 2; ++s2) { const bf16x8 qf = *(const bf16x8*)(qp + (jt * 2 + s2) * 16);
#pragma unroll
                    for (int i2 = 0; i2 < 2; ++i2) y[i2] = MFMA32(Sb[jt][s2][i2], qf, y[i2]); }
#pragma unroll
            for (int i2 = 0; i2 < 2; ++i2)
#pragma unroll
                for (int g = 0; g < 4; ++g) *(u32x2*)(yp + 32 * i2 + 8 * g) = (u32x2){pk2(y[i2][4 * g], y[i2][4 * g + 1]), pk2(y[i2][4 * g + 2], y[i2][4 * g + 3])};
        }
    }
}
#ifndef REP_MASK
#define REP_MASK 0
#endif
#ifndef EN_MASK
#define EN_MASK 0xffff
#endif
#define EN(k) (((EN_MASK) >> (k)) & 1)
constexpr int NPHASE = 54;
constexpr int LDS_BYTES = 147456;
constexpr int LDS_BARST = 147200;
#define XB_TMO      128
#define XB_XCNT(j)  (256  + 64 * (j))
#define XB_XSUB(j)  (1280 + 64 * (j))
#define XB_XGEN(j)  (2304 + 64 * (j))
#define XB_TOP      3328
#define XB_TOPGEN   3392
#define XCD_BAR_WORDS 3456
#define XB_SPIN_CAP (1u << 18)

__device__ __forceinline__ unsigned xb_ld(unsigned* p)              { return __hip_atomic_load(p, __ATOMIC_RELAXED, __HIP_MEMORY_SCOPE_AGENT); }
__device__ __forceinline__ unsigned xb_add(unsigned* p, unsigned v) { return __hip_atomic_fetch_add(p, v, __ATOMIC_RELAXED, __HIP_MEMORY_SCOPE_AGENT); }
__device__ __forceinline__ unsigned xb_xcc_id() { return (unsigned)__builtin_amdgcn_s_getreg((3 << 11) | 20) & 0xFu; }
#define XB_SPIN(cond, bar) do { unsigned _sp = 0; while (cond) { __builtin_amdgcn_s_sleep(1); \
    if ((++_sp & 255u) == 0u) { if (xb_ld(&(bar)[XB_TMO])) break; if (_sp > XB_SPIN_CAP) { atomicAdd(&(bar)[XB_TMO], 1u); break; } } } } while (0)

struct XcdBarrier {
    unsigned* bar; unsigned x;
    volatile LAS unsigned* st;
};

__device__ __forceinline__ XcdBarrier xcd_barrier_post(unsigned* bar, volatile LAS unsigned* st) {
    XcdBarrier b; b.bar = bar; b.x = xb_xcc_id(); b.st = st;
    if (threadIdx.x == 0) (void)xb_add(&bar[XB_XCNT(b.x)], 1u);
    return b;
}
__device__ __forceinline__ void xcd_barrier_complete(unsigned* bar, unsigned x, unsigned& nloc, unsigned& nx) {
    const unsigned G = gridDim.x * gridDim.y * gridDim.z;
    unsigned sum, cnt, mine, sp = 0u;
    for (;;) {
        sum = 0u; cnt = 0u; mine = 0u;
#pragma unroll
        for (unsigned j = 0; j < 16; ++j) { const unsigned c = xb_ld(&bar[XB_XCNT(j)]); sum += c; cnt += (c > 0u) ? 1u : 0u; mine = (j == x) ? c : mine; }
        if (sum == G) break;
        __builtin_amdgcn_s_sleep(1);
        if ((++sp & 255u) == 0u) { if (xb_ld(&bar[XB_TMO])) break; if (sp > XB_SPIN_CAP) { atomicAdd(&bar[XB_TMO], 1u); break; } }
    }
    nloc = mine > 0u ? mine : 1u; nx = cnt > 0u ? cnt : 1u;
}

__device__ __forceinline__ void xcd_barrier(const XcdBarrier& b) {
    asm volatile("s_waitcnt vmcnt(0)" ::: "memory");
    __syncthreads();
    if (threadIdx.x == 0) {
        unsigned* bar = b.bar;
        __builtin_amdgcn_s_waitcnt(0);
        unsigned nloc = b.st[0], nx = b.st[1];
        if (nloc == 0u) { xcd_barrier_complete(bar, b.x, nloc, nx); b.st[0] = nloc; b.st[1] = nx; }
        const unsigned old = xb_add(&bar[XB_XSUB(b.x)], 1u);
        const unsigned gen = old / nloc;
        if (old + 1u == (gen + 1u) * nloc) {
            __builtin_amdgcn_fence(__ATOMIC_RELEASE, "agent");
            asm volatile("s_waitcnt vmcnt(0)" ::: "memory");
            const unsigned og = xb_add(&bar[XB_TOP], 1u);
            const unsigned tg = og / nx;
            if (og + 1u == (tg + 1u) * nx) xb_add(&bar[XB_TOPGEN], 1u);
            else XB_SPIN(xb_ld(&bar[XB_TOPGEN]) == tg, bar);
            __builtin_amdgcn_fence(__ATOMIC_ACQUIRE, "agent");
            xb_add(&bar[XB_XGEN(b.x)], 1u);
            asm volatile("s_waitcnt vmcnt(0)" ::: "memory");
        } else {
            XB_SPIN(xb_ld(&bar[XB_XGEN(b.x)]) == gen, bar);
            __builtin_amdgcn_fence(__ATOMIC_ACQUIRE, "agent");
            asm volatile("s_waitcnt vmcnt(0)" ::: "memory");
        }
    }
    __syncthreads();
}

__device__ __forceinline__ unsigned launder_s(unsigned x) { unsigned y; asm volatile("s_mov_b32 %0, %1" : "=s"(y) : "s"(x)); return y; }
__device__ __forceinline__ void* launder_ptr(const void* p) {
    const unsigned lo = launder_s((unsigned)(uintptr_t)p), hi = launder_s((unsigned)((uintptr_t)p >> 32));
    return (void*)(((uintptr_t)hi << 32) | (uintptr_t)lo);
}
__global__ void __launch_bounds__(512, 2) fwd_kernel(Args args) {
    extern __shared__ __attribute__((aligned(16))) unsigned char lds_raw[];
    Frame F;
    F.lds = (LAS unsigned char*)lds_raw;
    F.in = args.in; F.out = args.out; F.ws = args.ws;
    unsigned char* ws = args.ws;
    if (threadIdx.x == 0) { ((volatile LAS unsigned*)(F.lds + LDS_BARST))[0] = 0u; ((volatile LAS unsigned*)(F.lds + LDS_BARST))[1] = 0u; }
    __syncthreads();
    XcdBarrier xbar = xcd_barrier_post((unsigned*)args.ws, (volatile LAS unsigned*)(F.lds + LDS_BARST));
    bool first = true; int nseam = 0;
    for (int vp = 2 * args.ph_lo; vp < 2 * args.ph_hi; ++vp) {
        const int ph = vp >> 1, rep = vp & 1;
        { int t_ = threadIdx.x; asm volatile("" : "+v"(t_)); F.tid = t_; F.lane = t_ & 63; F.wave = __builtin_amdgcn_readfirstlane(t_ >> 6);
          F.bid = (int)launder_s(blockIdx.x); F.G = (int)launder_s(gridDim.x); }
        ws = (unsigned char*)launder_ptr(args.ws); F.ws = ws; F.out = (float*)launder_ptr(args.out); F.in = args.in;
        const float* modp = (const float*)(ws + WS_MOD);
        int kind, l = 0, s = 0;
        if (ph == 0) kind = 0; else if (ph == NPHASE - 1) kind = 11;
        int dsel = 0;
        if (ph != 0 && ph != NPHASE - 1) { int q = ph - 1; if (q < 16) { l = 0; } else if (q < 26) { l = 1; q -= 16; } else if (q < 42) { l = 2; q -= 26; } else { l = 3; q -= 42; }
            if (!(l & 1)) { kind = (int)((0x32176fedfc541321ull >> (4 * q)) & 15ull); s = (int)((0x1120000000001000ull >> (4 * q)) & 15ull); dsel = q >= 8; }
            else { kind = (int)((0x321a981321ull >> (4 * q)) & 15ull); s = (int)((0x1120001000ull >> (4 * q)) & 15ull); } }
        const int jl = l >> 1;
        if (rep && !((REP_MASK >> kind) & 1)) continue;
        const float rscale = rep ? 0.f : 1.f;
        if (!first) { if (nseam == 0) { __threadfence(); cg::this_grid().sync(); } else xcd_barrier(xbar); ++nseam; }
        first = false;
        if (kind == 0) { if (EN(0)) prologue(F); }
        else if (kind == 1) { if (EN(1)) norm_phase(F, l, s); }
        else if (kind == 2) { if (EN(2)) {
            pg8::Gemm g{(const pg8::bf16_t*)(ws + WS_H), (const pg8::bf16_t*)(ws + WS_W13) + (size_t)(l * 2 + s) * 5632 * 1024, MTOK, 5632, 1024, 1024};
            pg8::StaticOrder S; S.init(MTOK, 5632, F.G, F.bid); pg8::EpiSwiGLU E{(pg8::bf16_t*)(ws + WS_G)};
            pg8::gemm_phase<pg8::EpiSwiGLU, pg8::StaticOrder, true, true>(F.lds, g, S, E, F.tid); }
        } else if (kind == 3) { if (EN(3)) {
            pg8::Gemm g{(const pg8::bf16_t*)(ws + WS_G), (const pg8::bf16_t*)(ws + WS_W2) + (size_t)(l * 2 + s) * 1024 * 2816, MTOK, 1024, 2816, 2816};
            pg8::StaticOrder S; S.init(MTOK, 1024, F.G, F.bid); pg8::EpiResid<false> E{F.out, modp + (size_t)l * 9 * 9216 + (s == 0 ? 2 : 8) * 1024, 0.5f * rscale};
            pg8::gemm_phase<pg8::EpiResid<false>, pg8::StaticOrder, true, true>(F.lds, g, S, E, F.tid); }
        } else if (kind == 4) { if (EN(4)) {
            pg8::Gemm g{(const pg8::bf16_t*)(ws + WS_H), (const pg8::bf16_t*)(ws + WS_WAB) + (size_t)jl * 2816 * 1024, MTOK, 2816, 1024, 1024};
            pg8::StaticOrder S; S.init(MTOK, 2816, F.G, F.bid);
            pg8::EpiProj<0> E{(pg8::bf16_t*)(ws + WS_G), (pg8::bf16_t*)(ws + WS_G + G_VTA), (const float*)(ws + WS_ROPE), (const float*)(ws + WS_ROPE) + 1024, F.out + O_AK, F.out + O_AV, jl};
            pg8::gemm_phase<pg8::EpiProj<0>, pg8::StaticOrder, true, true>(F.lds, g, S, E, F.tid); }
        } else if (kind == 5) {
            if (EN(5)) rwkv_r1(F, jl, 0);
        } else if (kind == 6) { if (EN(6)) rwkv_post_phase(F, jl); }
        else if (kind == 12 || kind == 14) { if (F.wave < 2) { if (EN(13)) rwkv_r2a(F, jl, kind == 14 ? 1 : 0); } if (EN(12) && !rep) attnA_phase(F, jl); }
        else if (kind == 13) { if (EN(5)) rwkv_r1(F, jl, 1); }
        else if (kind == 15) { if (EN(13)) rwkv_r2b(F, jl, dsel); if (EN(12) && !rep) attnA_phase(F, jl); }
        else if (kind == 7 || kind == 10) { if (EN(7)) {
            pg8::Gemm g{(const pg8::bf16_t*)(ws + WS_H), (const pg8::bf16_t*)(ws + (kind == 7 ? WS_WABO : WS_WCO)) + (size_t)jl * 1024 * 1024, MTOK, 1024, 1024, 1024};
            pg8::StaticOrder S; S.init(MTOK, 1024, F.G, F.bid); pg8::EpiResid<false> E{F.out, modp + (size_t)l * 9 * 9216 + 5 * 1024, rscale};
            pg8::gemm_phase<pg8::EpiResid<false>, pg8::StaticOrder, true, true>(F.lds, g, S, E, F.tid); }
        } else if (kind == 8) { if (EN(8)) {
            pg8::Gemm g{(const pg8::bf16_t*)(ws + WS_H), (const pg8::bf16_t*)(ws + WS_WC) + (size_t)jl * 3072 * 1024, MTOK, 3072, 1024, 1024};
            pg8::StaticOrder S; S.init(MTOK, 3072, F.G, F.bid);
            pg8::EpiProj<1> E{(pg8::bf16_t*)(ws + WS_G), (pg8::bf16_t*)(ws + WS_G + G_VTC), (const float*)(ws + WS_ROPE), (const float*)(ws + WS_ROPE) + 1024, F.out + O_CK, F.out + O_CV, jl};
            pg8::gemm_phase<pg8::EpiProj<1>, pg8::StaticOrder, true, true>(F.lds, g, S, E, F.tid); }
        } else if (kind == 9) { if (EN(9)) attnC2_phase(F, jl, l); }
        else { if (EN(11)) final_norm_phase(F); }

    }
}
#ifndef MK_ONE_LAUNCH
#define MK_ONE_LAUNCH 1
#endif
extern "C" void kernel_launch(void* const* d_in, const int* in_sizes, int n_in, void* d_out, int out_size, void* d_ws, size_t ws_size, hipStream_t stream) {
    static int grid = 0;
    if (grid == 0) {
        if (n_in != 38 || (size_t)out_size != O_END || ws_size < WS_END2) { fprintf(stderr, "kernel_launch: unexpected sizes n_in %d out %d ws %zu (need %zu)\n", n_in, out_size, ws_size, (size_t)WS_END2); grid = -1; return; }
        int dev = 0, cus = 0, per = 0;
        (void)hipGetDevice(&dev); (void)hipDeviceGetAttribute(&cus, hipDeviceAttributeMultiprocessorCount, dev);
        (void)hipFuncSetAttribute((const void*)fwd_kernel, hipFuncAttributeMaxDynamicSharedMemorySize, LDS_BYTES);
        (void)hipOccupancyMaxActiveBlocksPerMultiprocessor(&per, (const void*)fwd_kernel, 512, LDS_BYTES);
        if (per < 1) { fprintf(stderr, "kernel_launch: occupancy query says %d blocks per CU\n", per); per = 1; }
        grid = cus;
        (void)hipGetLastError();
    }
    if (grid < 0) return;
    Args a{};
    for (int i = 0; i < 38; ++i) a.in[i] = (const float*)d_in[i];
    a.out = (float*)d_out; a.ws = (unsigned char*)d_ws;
#if MK_ONE_LAUNCH
    (void)hipMemsetAsync(d_ws, 0, 16384, stream);
    a.ph_lo = 0; a.ph_hi = NPHASE;
    void* kargs[] = {&a};
    hipError_t e = hipLaunchCooperativeKernel((const void*)fwd_kernel, dim3(grid), dim3(512), kargs, LDS_BYTES, stream);
    if (e != hipSuccess) fprintf(stderr, "cooperative launch failed: %s\n", hipGetErrorString(e));
#else
    for (int ph = 0; ph < NPHASE; ++ph) { a.ph_lo = ph; a.ph_hi = ph + 1; hipLaunchKernelGGL(fwd_kernel, dim3(grid), dim3(512), LDS_BYTES, stream, a); }
#endif
}
```

```cpp
#include <hip/hip_runtime.h>
#include <hip/hip_cooperative_groups.h>
#include <cstdio>
#include <cstdint>
namespace cg = cooperative_groups;

constexpr int DM = 1024, MTOK = 40960, MPR = 8192, TP = 256, TL = 4096, NSEQP = 32, NSEQL = 8;
constexpr int DFF = 2816, ABC = 2688, ABCP = 2816, CC = 3072, NMOD = 9, MODW = 9216;
constexpr int PLD_AB = 2816, PLD_C = 2048;
namespace pg8 {
#define PG8_LAS __attribute__((address_space(3)))
typedef unsigned short bf16_t;
typedef short bf16x8 __attribute__((ext_vector_type(8)));
typedef float f32x4 __attribute__((ext_vector_type(4)));
typedef unsigned u32x4 __attribute__((ext_vector_type(4)));
constexpr int BM = 256, BK = 64, HALF = 128, HTB = HALF * BK * 2  , STAGE_BYTES = 8 * HTB, NXCD = 8, WGM = 4;

__host__ __device__ __forceinline__ int lds_byte(int r, int c) { const int st = (r >> 4) * 2 + (c >> 5), rr = r & 15, cc = c & 31, ob = rr * 64 + cc * 2; return st * 1024 + (ob ^ (((ob >> 9) & 1) << 5)); }
__host__ __device__ __forceinline__ void stage_rc(int b, int& R, int& C) { const int st = b / 1024, sb = b % 1024, swz = sb ^ (((sb >> 9) & 1) << 5); R = (st >> 1) * 16 + swz / 64; C = (st & 1) * 32 + (swz % 64) / 2; }
__host__ __device__ __forceinline__ int perm32(int rho) { const int n = rho >> 4, i = rho & 15; return 8 * (i >> 2) + 4 * n + (i & 3); }

struct Unit { int pm, pn, kq; };
struct Gemm { const bf16_t* A; const bf16_t* Bt; int M, N, K, ld; };

struct StaticOrder {
    int nM, nN, nwg, G, c;
    __host__ __device__ void init(int M, int N, int G_, int c_) { nM = M / BM; nN = N / BM; nwg = nM * nN; G = G_; c = c_; }
    __host__ __device__ bool next(int i, Unit& u) const {
        const long L = (long)i * G + c; if (L >= nwg) return false;
        int wgid = (int)L; { const int q = nwg / NXCD, r = nwg % NXCD, xcd = wgid % NXCD, off = wgid / NXCD; wgid = (xcd < r ? xcd * (q + 1) : r * (q + 1) + (xcd - r) * q) + off; }
        const int nig = WGM * nN, gid = wgid / nig, fm = gid * WGM, gsz = (nM - fm) < WGM ? (nM - fm) : WGM;
        u.pm = fm + ((wgid % nig) % gsz); u.pn = (wgid % nig) / gsz; u.kq = 0; return true;
    }
    __device__ __forceinline__ void a_ready(const Unit&) const {}
    __device__ __forceinline__ void done(const Unit&) const {}
};
struct SplitOrder {
    int nM, nN, nwg, G, c;
    __host__ __device__ void init(int M, int N, int G_, int c_) { nM = M / BM; nN = N / BM; nwg = 2 * nM * nN; G = G_; c = c_; }
    __host__ __device__ bool next(int i, Unit& u) const {
        const long L = (long)i * G + c; if (L >= nwg) return false;
        int wgid = (int)L; { const int q = nwg / NXCD, r = nwg % NXCD, xcd = wgid % NXCD, off = wgid / NXCD; wgid = (xcd < r ? xcd * (q + 1) : r * (q + 1) + (xcd - r) * q) + off; }
        u.kq = wgid & 1; wgid >>= 1;
        const int nig = WGM * nN, gid = wgid / nig, fm = gid * WGM, gsz = (nM - fm) < WGM ? (nM - fm) : WGM;
        u.pm = fm + ((wgid % nig) % gsz); u.pn = (wgid % nig) / gsz; return true;
    }
    __device__ __forceinline__ void a_ready(const Unit&) const {}
    __device__ __forceinline__ void done(const Unit&) const {}
};


__device__ __forceinline__ unsigned cvt_pk_bf16(float lo, float hi) { unsigned r; asm volatile("v_cvt_pk_bf16_f32 %0, %1, %2" : "=v"(r) : "v"(lo), "v"(hi)); return r; }
typedef float f32x2 __attribute__((ext_vector_type(2)));
typedef float f32x2 __attribute__((ext_vector_type(2)));
__device__ __forceinline__ float silu_f(float x) { return x * __builtin_amdgcn_rcpf(1.0f + __builtin_amdgcn_exp2f(-1.4426950408889634f * x)); }
struct EpiSwiGLU {
    static constexpr bool PERM = true, AFTER_DRAIN = false;
    bf16_t* G;
    __device__ __forceinline__ void operator()(const f32x4 (&acc)[2][2][4][2], const Unit& u, int wr, int wc, int fr, int fq) const {
        const int row0 = u.pm * BM + wr * 64 + fr; const int col0 = u.pn * 128 + wc * 32 + 8 * fq;
#pragma unroll
        for (int ai = 0; ai < 2; ++ai)
#pragma unroll
            for (int m = 0; m < 4; ++m) {
                bf16_t* rowp = G + (size_t)(row0 + ai * HALF + m * 16) * 2816 + col0;
                const f32x4 g0 = acc[ai][0][m][0], g1 = acc[ai][0][m][1], u0 = acc[ai][1][m][0], u1 = acc[ai][1][m][1];
                u32x4 w;
                w.x = cvt_pk_bf16(silu_f(g0[0]) * u0[0], silu_f(g0[1]) * u0[1]); w.y = cvt_pk_bf16(silu_f(g0[2]) * u0[2], silu_f(g0[3]) * u0[3]);
                w.z = cvt_pk_bf16(silu_f(g1[0]) * u1[0], silu_f(g1[1]) * u1[1]); w.w = cvt_pk_bf16(silu_f(g1[2]) * u1[2], silu_f(g1[3]) * u1[3]);
                *(u32x4*)rowp = w;
            }
    }
};
template <bool ATOMIC> struct EpiResid {
    static constexpr bool PERM = false, AFTER_DRAIN = false;
    float* X; const float* gate; float scale;
    __device__ __forceinline__ void operator()(const f32x4 (&acc)[2][2][4][2], const Unit& u, int wr, int wc, int fr, int fq) const {
        const int r0 = u.pm * BM; const int cidx = (r0 < 8192) ? 8 : ((r0 - 8192) >> 12);
        const float* gp = gate + (size_t)cidx * 9216;
        const int col0 = u.pn * BM + wc * 32 + 4 * fq;
#pragma unroll
        for (int bj = 0; bj < 2; ++bj)
#pragma unroll
            for (int n = 0; n < 2; ++n) {
                const f32x4 gv = *(const f32x4*)(gp + col0 + bj * HALF + n * 16) * scale;
#pragma unroll
                for (int ai = 0; ai < 2; ++ai)
#pragma unroll
                    for (int m = 0; m < 4; ++m) {
                        float* p = X + (size_t)(r0 + ai * HALF + wr * 64 + m * 16 + fr) * 1024 + col0 + bj * HALF + n * 16;
                        if (ATOMIC) { const f32x4 dlt = gv * acc[ai][bj][m][n];
#pragma unroll
                            for (int j = 0; j < 4; ++j) unsafeAtomicAdd(p + j, dlt[j]); }
                        else { f32x4 x = *(f32x4*)p; x = x + gv * acc[ai][bj][m][n]; *(f32x4*)p = x; }
                    }
            }
    }
};
template <int MODE> struct EpiProj {
    static constexpr bool PERM = true, AFTER_DRAIN = false;
    bf16_t* P; bf16_t* Vt; const float* ropec; const float* ropes; float* outK; float* outV; int jl;
    __device__ __forceinline__ void operator()(const f32x4 (&acc)[2][2][4][2], const Unit& u, int wr, int wc, int fr, int fq) const {
        constexpr int LDP = MODE == 0 ? 2816 : 2048;
        const int r0 = u.pm * BM; const bool prompt = r0 < 8192;
#pragma unroll
        for (int bj = 0; bj < 2; ++bj) {
            const int seg = 2 * u.pn + bj;
            int kind;
            int kbase, vbase, okw;
            if (MODE == 0) { kind = seg < 4 ? 1 : seg == 4 ? 2 : seg == 5 ? 3 : seg <= 20 ? 0 : 4; kbase = 512; vbase = 640; okw = 128; }
            else { kind = seg < 8 ? 1 : seg < 16 ? 2 : 3; kbase = 1024; vbase = 2048; okw = 1024; }
            if (kind == 4) continue;
            const int cseg = seg * 128 + wc * 32 + 8 * fq;
#pragma unroll
            for (int ai = 0; ai < 2; ++ai)
#pragma unroll
                for (int m = 0; m < 4; ++m) {
                    const int r = r0 + ai * HALF + wr * 64 + m * 16 + fr;
                    f32x4 v0 = acc[ai][bj][m][0], v1 = acc[ai][bj][m][1];
                    if ((kind == 2 || kind == 3) && prompt) {
                        float* o = (kind == 2 ? outK : outV) + ((size_t)((r >> 8) * 2 + jl) * 256 + (r & 255)) * okw + (cseg - (kind == 2 ? kbase : vbase));
                        *(f32x4*)o = v0; *(f32x4*)(o + 4) = v1;
                    }
                    if ((kind == 1 || kind == 2) && !prompt) {
                        const int t = (r - 8192) & 4095; const int pos = (wc & 1) ? (t & 63) : (t >> 6);
                        const float sg = (fq < 2) ? -1.0f : 1.0f;
                        { const f32x4 c0 = *(const f32x4*)(ropec + pos * 16 + 8 * (fq & 1)), s0 = *(const f32x4*)(ropes + pos * 16 + 8 * (fq & 1)); f32x4 p0;
#pragma unroll
                          for (int j = 0; j < 4; ++j) p0[j] = __shfl_xor(v0[j], 32);
                          v0 = v0 * c0 + (p0 * s0) * sg; }
                        { const f32x4 c1 = *(const f32x4*)(ropec + pos * 16 + 8 * (fq & 1) + 4), s1 = *(const f32x4*)(ropes + pos * 16 + 8 * (fq & 1) + 4); f32x4 p1;
#pragma unroll
                          for (int j = 0; j < 4; ++j) p1[j] = __shfl_xor(v1[j], 32);
                          v1 = v1 * c1 + (p1 * s1) * sg; }
                    }
                    if (kind == 3) {
                        bf16_t* vp = Vt + (size_t)(cseg - vbase) * ::MTOK + r;
#pragma unroll
                        for (int j = 0; j < 4; ++j) { vp[(size_t)j * ::MTOK] = (bf16_t)(cvt_pk_bf16(v0[j], 0.f) & 0xffffu); vp[(size_t)(j + 4) * ::MTOK] = (bf16_t)(cvt_pk_bf16(v1[j], 0.f) & 0xffffu); }
                    } else {
                        u32x4 w; w.x = cvt_pk_bf16(v0[0], v0[1]); w.y = cvt_pk_bf16(v0[2], v0[3]); w.z = cvt_pk_bf16(v1[0], v1[1]); w.w = cvt_pk_bf16(v1[2], v1[3]);
                        *(u32x4*)(P + (size_t)r * LDP + cseg) = w;
                    }
                    asm volatile("" ::: "memory");
                }
        }
    }
};
template <class Epi, class Sched, bool ALIGN_EPI = false, bool SP2 = false>
__device__ __forceinline__ void gemm_phase(PG8_LAS unsigned char* lds, const Gemm g, const Sched& S, const Epi& E, const int tid) {
    const int wid = __builtin_amdgcn_readfirstlane(tid >> 6), lane = tid & 63, wr = wid >> 2, wc = wid & 3, fr = lane & 15, fq = lane >> 4;
    const int K = g.ld, nt = g.K / BK;
    const size_t qstep = (size_t)g.K * 2;
    unsigned voffA[2], voffB[2];
#pragma unroll
    for (int i = 0; i < 2; ++i) { int R, C; stage_rc(tid * 16 + i * 8192, R, C); const int Rb = Epi::PERM ? ((R & ~31) + perm32(R & 31)) : R;
        voffA[i] = (unsigned)(R * K + C) * 2u; voffB[i] = (unsigned)(Rb * K + C) * 2u; }
    const size_t kstep = (size_t)(BK * 2);
    const size_t hstep = (size_t)HALF * K * 2;
    const size_t tstep = 2 * hstep;
    const unsigned ldsw = (unsigned)wid * 1024u;
    const int aoff = lds_byte(wr * 64 + fr, fq * 8), boff = lds_byte(wc * 32 + fr, fq * 8);
#define PG8_SA(b, h) (((b) * 2 + (h)) * HTB)
#define PG8_SB(b, h) ((4 + (b) * 2 + (h)) * HTB)
#define PG8_STAGE(bufoff, gbase, voff) do { _Pragma("unroll") for (int _i = 0; _i < 2; ++_i) \
        __builtin_amdgcn_global_load_lds((const unsigned*)((const char*)(gbase) + (voff)[_i]), (PG8_LAS unsigned*)(lds + (bufoff) + ldsw + _i * 8192), 16, 0, 0); } while (0)
#define PG8_LDA(dst, b, h) do { _Pragma("unroll") for (int m = 0; m < 4; ++m) _Pragma("unroll") for (int k = 0; k < 2; ++k) dst[m][k] = *(const PG8_LAS bf16x8*)(lds + PG8_SA(b, h) + aoff + m * 2048 + k * 1024); } while (0)
#define PG8_LDB(dst, b, h) do { _Pragma("unroll") for (int n = 0; n < 2; ++n) _Pragma("unroll") for (int k = 0; k < 2; ++k) dst[n][k] = *(const PG8_LAS bf16x8*)(lds + PG8_SB(b, h) + boff + n * 2048 + k * 1024); } while (0)
#define PG8_MMA(ai, bj, At, Bt) do { __builtin_amdgcn_s_setprio(1); _Pragma("unroll") for (int m = 0; m < 4; ++m) _Pragma("unroll") for (int n = 0; n < 2; ++n) _Pragma("unroll") for (int k = 0; k < 2; ++k) \
        acc[ai][bj][m][n] = __builtin_amdgcn_mfma_f32_16x16x32_bf16(Bt[n][k], At[m][k], acc[ai][bj][m][n], 0, 0, 0); __builtin_amdgcn_s_setprio(0); } while (0)
#define PG8_WAIT_V(n) asm volatile("s_waitcnt vmcnt(" #n ")" ::: "memory")
#define PG8_WAIT_L(n) asm volatile("s_waitcnt lgkmcnt(" #n ")" ::: "memory")
#define PG8_BAR __builtin_amdgcn_s_barrier()
#define PG8_SCHED __builtin_amdgcn_sched_barrier(0)
    Unit cur, nxt; int ui = 0;
    float zf_ = 0.f; asm volatile("" : "+v"(zf_));
    if (!S.next(0, cur)) return;
    f32x4 acc[2][2][4][2];
#pragma unroll
    for (int a = 0; a < 2; ++a)
#pragma unroll
        for (int b = 0; b < 2; ++b)
#pragma unroll
            for (int m = 0; m < 4; ++m)
#pragma unroll
                for (int n = 0; n < 2; ++n) acc[a][b][m][n] = (f32x4){zf_, zf_, zf_, zf_};
    bf16x8 At[4][2], B0[2][2], B1[2][2];
    const char* cA = (const char*)g.A + (size_t)cur.pm * tstep + (size_t)cur.kq * qstep; const char* cB = (const char*)g.Bt + (size_t)cur.pn * tstep + (size_t)cur.kq * qstep;
    S.a_ready(cur);
    if constexpr (SP2) {
        PG8_STAGE(PG8_SB(0, 0), cB, voffB); PG8_STAGE(PG8_SB(0, 1), cB + hstep, voffB); PG8_STAGE(PG8_SA(0, 0), cA, voffA); PG8_STAGE(PG8_SA(0, 1), cA + hstep, voffA);
        if (wr == 1) PG8_BAR;
        PG8_WAIT_V(2); PG8_BAR;
        PG8_STAGE(PG8_SB(1, 0), cB + kstep, voffB); PG8_STAGE(PG8_SA(1, 0), cA + kstep, voffA); PG8_STAGE(PG8_SB(1, 1), cB + hstep + kstep, voffB);
        PG8_WAIT_V(6); PG8_BAR;
    } else {
        PG8_STAGE(PG8_SB(0, 0), cB, voffB); PG8_STAGE(PG8_SA(0, 0), cA, voffA); PG8_STAGE(PG8_SB(0, 1), cB + hstep, voffB); PG8_STAGE(PG8_SA(0, 1), cA + hstep, voffA);
        if (wr == 1) PG8_BAR;
        PG8_WAIT_V(4); PG8_BAR;
        PG8_STAGE(PG8_SB(1, 0), cB + kstep, voffB); PG8_STAGE(PG8_SA(1, 0), cA + kstep, voffA); PG8_STAGE(PG8_SB(1, 1), cB + hstep + kstep, voffB);
        PG8_WAIT_V(6); PG8_BAR;
    }
    for (;;) {
        const bool has_next = S.next(ui + 1, nxt);
        const char* nA = has_next ? (const char*)g.A + (size_t)nxt.pm * tstep + (size_t)nxt.kq * qstep : cA; const char* nB = has_next ? (const char*)g.Bt + (size_t)nxt.pn * tstep + (size_t)nxt.kq * qstep : cB;
        for (int t = 0; t < nt; t += 2) {
            const bool last = (t == nt - 2);
            const char* a1 = cA + (size_t)(t + 1) * kstep;
            const char* a2 = last ? nA : cA + (size_t)(t + 2) * kstep; const char* b2 = last ? nB : cB + (size_t)(t + 2) * kstep;
            const char* a3 = a2 + kstep; const char* b3 = b2 + kstep;
            if (last && has_next) S.a_ready(nxt);
            if constexpr (SP2) {
            PG8_LDB(B0, 0, 0); PG8_LDB(B1, 0, 1); PG8_SCHED; PG8_LDA(At, 0, 0); PG8_STAGE(PG8_SA(1, 1), a1 + hstep, voffA);
            PG8_WAIT_V(8); PG8_WAIT_L(0); PG8_BAR; PG8_MMA(0, 0, At, B0); PG8_MMA(0, 1, At, B1); PG8_BAR; PG8_SCHED;
            PG8_LDA(At, 0, 1); PG8_STAGE(PG8_SB(0, 0), b2, voffB); PG8_STAGE(PG8_SB(0, 1), b2 + hstep, voffB); PG8_STAGE(PG8_SA(0, 0), a2, voffA);
            PG8_WAIT_V(8); PG8_WAIT_L(0); PG8_BAR; PG8_MMA(1, 0, At, B0); PG8_MMA(1, 1, At, B1); PG8_BAR; PG8_SCHED;
            PG8_LDB(B0, 1, 0); PG8_LDB(B1, 1, 1); PG8_SCHED; PG8_LDA(At, 1, 0); PG8_STAGE(PG8_SA(0, 1), a2 + hstep, voffA);
            PG8_WAIT_V(8); PG8_WAIT_L(0); PG8_BAR; PG8_MMA(0, 0, At, B0); PG8_MMA(0, 1, At, B1); PG8_BAR; PG8_SCHED;
            PG8_LDA(At, 1, 1); PG8_STAGE(PG8_SB(1, 0), b3, voffB); PG8_STAGE(PG8_SB(1, 1), b3 + hstep, voffB); PG8_STAGE(PG8_SA(1, 0), a3, voffA);
            PG8_WAIT_V(8); PG8_WAIT_L(0); PG8_BAR; PG8_MMA(1, 0, At, B0); PG8_MMA(1, 1, At, B1); PG8_BAR; PG8_SCHED;
            } else {
            PG8_LDB(B0, 0, 0); PG8_SCHED; PG8_LDA(At, 0, 0); PG8_STAGE(PG8_SA(1, 1), a1 + hstep, voffA);
            PG8_WAIT_L(8); PG8_BAR; PG8_WAIT_L(0); PG8_MMA(0, 0, At, B0); PG8_BAR; PG8_SCHED;
            PG8_LDB(B1, 0, 1); PG8_STAGE(PG8_SB(0, 0), b2, voffB);
            PG8_BAR; PG8_WAIT_L(0); PG8_MMA(0, 1, At, B1); PG8_BAR;
            PG8_LDA(At, 0, 1); PG8_STAGE(PG8_SA(0, 0), a2, voffA);
            PG8_BAR; PG8_WAIT_L(0); PG8_MMA(1, 0, At, B0); PG8_BAR; PG8_SCHED;
            PG8_STAGE(PG8_SB(0, 1), b2 + hstep, voffB);
            PG8_WAIT_V(6); PG8_BAR; PG8_MMA(1, 1, At, B1); PG8_BAR;
            PG8_LDB(B0, 1, 0); PG8_SCHED; PG8_LDA(At, 1, 0); PG8_STAGE(PG8_SA(0, 1), a2 + hstep, voffA);
            PG8_WAIT_L(8); PG8_BAR; PG8_WAIT_L(0); PG8_MMA(0, 0, At, B0); PG8_BAR; PG8_SCHED;
            PG8_LDB(B1, 1, 1); PG8_STAGE(PG8_SB(1, 0), b3, voffB);
            PG8_BAR; PG8_WAIT_L(0); PG8_MMA(0, 1, At, B1); PG8_BAR;
            PG8_LDA(At, 1, 1); PG8_STAGE(PG8_SA(1, 0), a3, voffA);
            PG8_BAR; PG8_WAIT_L(0); PG8_MMA(1, 0, At, B0); PG8_BAR; PG8_SCHED;
            PG8_STAGE(PG8_SB(1, 1), b3 + hstep, voffB);
            PG8_WAIT_V(6); PG8_BAR; PG8_MMA(1, 1, At, B1); PG8_BAR;
            }
        }
        if constexpr (ALIGN_EPI) { if (wr == 0) PG8_BAR; }
        if constexpr (!Epi::AFTER_DRAIN) { E(acc, cur, wr, wc, fr, fq); S.done(cur); }
        if (!has_next) break;
#pragma unroll
        for (int a = 0; a < 2; ++a)
#pragma unroll
            for (int b = 0; b < 2; ++b)
#pragma unroll
                for (int m = 0; m < 4; ++m)
#pragma unroll
                    for (int n = 0; n < 2; ++n) acc[a][b][m][n] = (f32x4){zf_, zf_, zf_, zf_};
        cur = nxt; cA = nA; cB = nB; ++ui;
        if constexpr (ALIGN_EPI) { if (wr == 1) PG8_BAR; }
    }
    PG8_WAIT_V(0);
    if constexpr (!ALIGN_EPI) { if (wr == 0) PG8_BAR; }
    PG8_BAR;
    if constexpr (Epi::AFTER_DRAIN) { E.fused(acc, cur, wr, wc, fr, fq, lds, wid, lane); S.done(cur); }
#undef PG8_SA
#undef PG8_SB
#undef PG8_STAGE
#undef PG8_LDA
#undef PG8_LDB
#undef PG8_MMA
#undef PG8_WAIT_V
#undef PG8_WAIT_L
#undef PG8_BAR
#undef PG8_SCHED
}
}
#define LAS __attribute__((address_space(3)))
typedef unsigned short bf16;
typedef float f32x4 __attribute__((ext_vector_type(4)));
typedef float f32x16 __attribute__((ext_vector_type(16)));
typedef short bf16x8 __attribute__((ext_vector_type(8)));
typedef short s16x4 __attribute__((ext_vector_type(4)));
typedef unsigned u32x4 __attribute__((ext_vector_type(4)));
typedef unsigned u32x2 __attribute__((ext_vector_type(2)));
#define MFMA32(a, b, c) __builtin_amdgcn_mfma_f32_32x32x16_bf16((a), (b), (c), 0, 0, 0)
__device__ __forceinline__ unsigned f2bf(float f) { unsigned u = __builtin_bit_cast(unsigned, f); return (u + 0x7fffu + ((u >> 16) & 1u)) >> 16; }
typedef float f32x2_t __attribute__((ext_vector_type(2))); typedef __bf16 bf16x2_t __attribute__((ext_vector_type(2)));
__device__ __forceinline__ unsigned pk2(float lo, float hi) { const f32x2_t v = {lo, hi}; const bf16x2_t q = __builtin_convertvector(v, bf16x2_t); return __builtin_bit_cast(unsigned, q); }
__device__ __forceinline__ float bf2f(unsigned short b) { return __builtin_bit_cast(float, (unsigned)b << 16); }
__device__ __forceinline__ int crow(int reg, int h) { return (reg & 3) + 8 * (reg >> 2) + 4 * h; }
__device__ __forceinline__ float wave_sum(float v) {
#pragma unroll
    for (int o = 1; o < 64; o <<= 1) v += __shfl_xor(v, o);
    return v;
}
constexpr size_t MiB = 1u << 20;
constexpr size_t WS_MOD = 1 * MiB;
constexpr size_t WS_ROPE = 3 * MiB;
constexpr size_t WS_BC = 4 * MiB;
constexpr size_t WS_W13 = 8 * MiB;
constexpr size_t WS_W2 = WS_W13 + 88 * MiB;
constexpr size_t WS_WAB = WS_W2 + 44 * MiB;
constexpr size_t WS_WABO = WS_WAB + 11 * MiB;
constexpr size_t WS_WC = WS_WABO + 4 * MiB;
constexpr size_t WS_WCO = WS_WC + 12 * MiB;
constexpr size_t WS_KAC = WS_WCO + 4 * MiB;
constexpr size_t WS_VAC = WS_KAC + 2 * MiB;
constexpr size_t WS_KCC = WS_VAC + 2 * MiB;
constexpr size_t WS_VCC = WS_KCC + 16 * MiB;
constexpr size_t WS_H = WS_VCC + 16 * MiB;
constexpr size_t WS_Y = WS_H + 80 * MiB;
constexpr size_t WS_G = WS_Y + 80 * MiB;
constexpr size_t WS_END = WS_G + 240 * MiB;
constexpr size_t G_VTA = (size_t)MTOK * 2816 * 2;
constexpr size_t G_VTC = (size_t)MTOK * 2048 * 2;
static_assert(G_VTA + (size_t)128 * MTOK * 2 <= 240 * MiB && G_VTC + (size_t)1024 * MTOK * 2 <= 240 * MiB, "G region");

struct Args {
    const float* in[38]; float* out; unsigned char* ws; int ph_lo, ph_hi;
};
struct Frame {
    LAS unsigned char* lds; int tid, lane, wave, G, bid;
    const float* const* in; float* out; unsigned char* ws;
};
constexpr size_t O_YP = 0, O_YS = (size_t)MPR * DM, O_AK = (size_t)MTOK * DM, O_AV = O_AK + (size_t)32 * 2 * 256 * 128, O_BW = O_AV + (size_t)32 * 2 * 256 * 128,
                 O_CK = O_BW + (size_t)32 * 2 * 2 * 8 * 64 * 64, O_CV = O_CK + (size_t)32 * 2 * 256 * 1024, O_END = O_CV + (size_t)32 * 2 * 256 * 1024;
enum { I_XP = 0, I_XS, I_C, I_CCTX, I_CAK, I_CAV, I_SB, I_CCK, I_CCV, I_NORMS, I_MODW, I_MODB, I_W1, I_W3, I_W2, I_WINAB, I_WOUTAB, I_SINK, I_MUP, I_MUN,
       I_BW0, I_BW2, I_BA0, I_BA2, I_BKK, I_BKA, I_BRK, I_BG2, I_GNW, I_GNB, I_WINC, I_WOUTC, I_LQ1, I_LK1, I_LQ2, I_LK2, I_SUBLN, I_FNORM };

__device__ __forceinline__ void transpose_item(const float* W, int K, int N, bf16* WT, int k0, int n0, int drow0, LAS float* scr, int lane) {
#pragma unroll 8
    for (int i = 0; i < 32; ++i) { const int kk = 2 * i + (lane >> 5); scr[kk * 33 + (lane & 31)] = W[(size_t)(k0 + kk) * N + n0 + (lane & 31)]; }
    asm volatile("s_waitcnt lgkmcnt(0)" ::: "memory");
    const int c = lane & 7;
#pragma unroll
    for (int j = 0; j < 4; ++j) { const int n = (lane >> 3) + 8 * j; const LAS float* s = scr + (8 * c) * 33 + n;
        u32x4 o; o.x = pk2(s[0 * 33], s[1 * 33]); o.y = pk2(s[2 * 33], s[3 * 33]); o.z = pk2(s[4 * 33], s[5 * 33]); o.w = pk2(s[6 * 33], s[7 * 33]);
        *(u32x4*)(WT + (size_t)(drow0 + n) * K + k0 + 8 * c) = o; }
    asm volatile("s_waitcnt lgkmcnt(0)" ::: "memory");
}
__device__ __forceinline__ void prologue(Frame& F) {
    unsigned char* ws = F.ws;
    LAS float* scr = (LAS float*)(F.lds + F.wave * 16384);
    const int gw = F.bid * 8 + F.wave, NGW = F.G * 8;
    const int gt = F.bid * 512 + F.tid, NGT = F.G * 512;
    constexpr int IT_W1 = 16 * 88, IT_W2 = 44 * 32, IT_AB = 16 * 84, IT_SQ = 16 * 32, IT_C = 16 * 96, IT_AV = 8 * 4, IT_CV = 8 * 32;
    constexpr int E0 = 8 * IT_W1, E1 = E0 + 8 * IT_W1, E2 = E1 + 8 * IT_W2, E3 = E2 + 2 * IT_AB, E4 = E3 + 2 * IT_SQ, E5 = E4 + 2 * IT_C, E6 = E5 + 2 * IT_SQ, E7 = E6 + 16 * IT_AV, E8a = E7 + 16 * IT_CV, E8b = E8a + 4 * 16, E8 = E8b + 4 * 16;
    for (int it = gw; it < E8; it += NGW) {
        const float* W; bf16* WT; int K, N, r, mode = 0;
        if (it < E0) { r = it; const int mi = r / IT_W1; r %= IT_W1; W = F.in[I_W1] + (size_t)mi * 1024 * 2816; WT = (bf16*)(ws + WS_W13) + (size_t)mi * 5632 * 1024; K = 1024; N = 2816; mode = 1; }
        else if (it < E1) { r = it - E0; const int mi = r / IT_W1; r %= IT_W1; W = F.in[I_W3] + (size_t)mi * 1024 * 2816; WT = (bf16*)(ws + WS_W13) + (size_t)mi * 5632 * 1024; K = 1024; N = 2816; mode = 2; }
        else if (it < E2) { r = it - E1; const int mi = r / IT_W2; r %= IT_W2; W = F.in[I_W2] + (size_t)mi * 2816 * 1024; WT = (bf16*)(ws + WS_W2) + (size_t)mi * 1024 * 2816; K = 2816; N = 1024; }
        else if (it < E3) { r = it - E2; const int mi = r / IT_AB; r %= IT_AB; W = F.in[I_WINAB] + (size_t)mi * 1024 * 2688; WT = (bf16*)(ws + WS_WAB) + (size_t)mi * 2816 * 1024; K = 1024; N = 2688; }
        else if (it < E4) { r = it - E3; const int mi = r / IT_SQ; r %= IT_SQ; W = F.in[I_WOUTAB] + (size_t)mi * 1024 * 1024; WT = (bf16*)(ws + WS_WABO) + (size_t)mi * 1024 * 1024; K = 1024; N = 1024; }
        else if (it < E5) { r = it - E4; const int mi = r / IT_C; r %= IT_C; W = F.in[I_WINC] + (size_t)mi * 1024 * 3072; WT = (bf16*)(ws + WS_WC) + (size_t)mi * 3072 * 1024; K = 1024; N = 3072; }
        else if (it < E6) { r = it - E5; const int mi = r / IT_SQ; r %= IT_SQ; W = F.in[I_WOUTC] + (size_t)mi * 1024 * 1024; WT = (bf16*)(ws + WS_WCO) + (size_t)mi * 1024 * 1024; K = 1024; N = 1024; }
        else if (it < E7) { r = it - E6; const int mi = r / IT_AV; r %= IT_AV; W = F.in[I_CAV] + (size_t)mi * 512 * 128; WT = (bf16*)(ws + WS_VAC) + (size_t)mi * 128 * 512; K = 512; N = 128; }
        else if (it < E8a) { r = it - E7; const int mi = r / IT_CV; r %= IT_CV; W = F.in[I_CCV] + (size_t)mi * 512 * 1024; WT = (bf16*)(ws + WS_VCC) + (size_t)mi * 1024 * 512; K = 512; N = 1024; }
        else if (it < E8b) { r = it - E8a; const int mi = r / 16; r %= 16; W = F.in[I_BW2] + (size_t)mi * 64 * 512; WT = (bf16*)(ws + (7 * MiB)) + (size_t)mi * 512 * 64; K = 64; N = 512; }
        else { r = it - E8b; const int mi = r / 16; r %= 16; W = F.in[I_BA2] + (size_t)mi * 64 * 512; WT = (bf16*)(ws + (7 * MiB)) + (size_t)(4 + mi) * 512 * 64; K = 64; N = 512; }
        const int nblk = N / 32, kb = r / nblk, nb = r % nblk, k0 = 64 * kb, n0 = 32 * nb;
        int drow0 = n0;
        if (mode) drow0 = (n0 >> 7) * 256 + (n0 & 127) + (mode == 2 ? 128 : 0);
        transpose_item(W, K, N, WT, k0, n0, drow0, scr, F.lane);
    }
    unsigned z_ = 0u; asm volatile("" : "+v"(z_));
    for (int i = gt; i < 2 * 128 * 1024 / 8; i += NGT) { const int mi = i / (128 * 1024 / 8), o = i % (128 * 1024 / 8);
        *(u32x4*)((bf16*)(ws + WS_WAB) + (size_t)mi * 2816 * 1024 + (size_t)2688 * 1024 + (size_t)o * 8) = (u32x4){z_, z_, z_, z_}; }
    for (int i = gt; i < 8 * 2 * 512 * 128 / 4; i += NGT) { const f32x4 v = ((const f32x4*)F.in[I_CAK])[i]; ((u32x2*)(ws + WS_KAC))[i] = (u32x2){pk2(v[0], v[1]), pk2(v[2], v[3])}; }
    for (int i = gt; i < 8 * 2 * 512 * 1024 / 4; i += NGT) { const f32x4 v = ((const f32x4*)F.in[I_CCK])[i]; ((u32x2*)(ws + WS_KCC))[i] = (u32x2){pk2(v[0], v[1]), pk2(v[2], v[3])}; }
    if (gt < 1024) { const int pos = gt >> 4, i = gt & 15; const float inv = powf(10000.0f, -(float)i / 16.0f); const float ang = (float)pos * inv;
        ((float*)(ws + WS_ROPE))[gt] = cosf(ang); ((float*)(ws + WS_ROPE))[1024 + gt] = sinf(ang); }
    __syncthreads();
    LAS float* sc = (LAS float*)F.lds;
    LAS float* red = sc + 9 * 1024;
    for (int i = F.tid; i < 9 * 1024; i += 512) { const float v = i < 8192 ? F.in[I_C][i] : F.in[I_CCTX][i - 8192]; sc[i] = v / (1.0f + __expf(-v)); }
    __syncthreads();
    for (int it = F.bid; it < 4 * 144; it += F.G) {
        const int l = it / 144, n0 = (it % 144) * 64;
        const float* W = F.in[I_MODW] + (size_t)l * 1024 * 9216 + n0 + F.lane;
        float a[9];
#pragma unroll
        for (int c = 0; c < 9; ++c) a[c] = 0.f;
        const int kb = F.wave * 128;
#pragma unroll 16
        for (int k = 0; k < 128; ++k) { const float w = W[(size_t)(kb + k) * 9216];
#pragma unroll
            for (int c = 0; c < 9; ++c) a[c] += sc[c * 1024 + kb + k] * w; }
#pragma unroll
        for (int c = 0; c < 9; ++c) red[(F.wave * 9 + c) * 64 + F.lane] = a[c];
        __syncthreads();
        for (int i = F.tid; i < 576; i += 512) { const int c = i >> 6, n = i & 63; float s = F.in[I_MODB][(size_t)l * 9216 + n0 + n];
#pragma unroll
            for (int w = 0; w < 8; ++w) s += red[(w * 9 + c) * 64 + n];
            ((float*)(ws + WS_MOD))[((size_t)l * 9 + c) * 9216 + n0 + n] = s; }
        __syncthreads();
    }
}
__device__ __forceinline__ void norm_phase(Frame& F, int l, int s) {
    const float* g = F.in[I_NORMS] + (size_t)(l * 3 + s) * 1024;
    const float* mod = (const float*)(F.ws + WS_MOD) + (size_t)l * 9 * 9216;
    bf16* H = (bf16*)(F.ws + WS_H);
    const int gw = F.bid * 8 + F.wave, NGW = F.G * 8;
    for (int m2 = gw; m2 < MTOK / 2; m2 += NGW) {
        const int m = 2 * m2;
        const int cidx = m < MPR ? 8 : ((m - MPR) >> 12);
        const float* sh = mod + (size_t)cidx * 9216 + (3 * s) * 1024; const float* scp = sh + 1024;
        const bool first = (l == 0 && s == 0);
        const float* xsrc = first ? (m < MPR ? F.in[I_XP] + (size_t)m * 1024 : F.in[I_XS] + (size_t)(m - MPR) * 1024) : F.out + (size_t)m * 1024;
        const f32x4* xr = (const f32x4*)xsrc + F.lane;
        f32x4 v[8]; float ss0 = 0.f, ss1 = 0.f;
#pragma unroll
        for (int j = 0; j < 8; ++j) v[j] = xr[64 * j];
        if (first) { f32x4* xo = (f32x4*)(F.out + (size_t)m * 1024) + F.lane;
#pragma unroll
            for (int j = 0; j < 8; ++j) xo[64 * j] = v[j]; }
#pragma unroll
        for (int j = 0; j < 4; ++j) { ss0 += (v[j].x * v[j].x + v[j].y * v[j].y) + (v[j].z * v[j].z + v[j].w * v[j].w); ss1 += (v[4 + j].x * v[4 + j].x + v[4 + j].y * v[4 + j].y) + (v[4 + j].z * v[4 + j].z + v[4 + j].w * v[4 + j].w); }
        const float rstd0 = 1.0f / sqrtf(wave_sum(ss0) * (1.0f / 1024.0f) + 1e-6f), rstd1 = 1.0f / sqrtf(wave_sum(ss1) * (1.0f / 1024.0f) + 1e-6f);
        u32x2* o = (u32x2*)(H + (size_t)m * 1024) + F.lane;
#pragma unroll
        for (int j = 0; j < 4; ++j) { const int c = 4 * F.lane + 256 * j; const f32x4 gg = *(const f32x4*)(g + c), s4 = *(const f32x4*)(scp + c) + 1.0f, h4 = *(const f32x4*)(sh + c);
            const f32x4 y0 = (v[j] * rstd0) * gg * s4 + h4, y1 = (v[4 + j] * rstd1) * gg * s4 + h4;
            o[64 * j] = (u32x2){pk2(y0.x, y0.y), pk2(y0.z, y0.w)}; o[256 + 64 * j] = (u32x2){pk2(y1.x, y1.y), pk2(y1.z, y1.w)}; }
    }
}
__device__ __forceinline__ void final_norm_phase(Frame& F) {
    const float* g = F.in[I_FNORM];
    const int gw = F.bid * 8 + F.wave, NGW = F.G * 8;
    for (int m = gw; m < MTOK; m += NGW) {
        f32x4* xr = (f32x4*)(F.out + (size_t)m * 1024) + F.lane;
        f32x4 v[4]; float ss = 0.f;
#pragma unroll
        for (int j = 0; j < 4; ++j) { v[j] = xr[64 * j]; ss += (v[j].x * v[j].x + v[j].y * v[j].y) + (v[j].z * v[j].z + v[j].w * v[j].w); }
        const float rstd = 1.0f / sqrtf(wave_sum(ss) * (1.0f / 1024.0f) + 1e-6f);
#pragma unroll
        for (int j = 0; j < 4; ++j) { const int c = 4 * F.lane + 256 * j; xr[64 * j] = (v[j] * rstd) * *(const f32x4*)(g + c); }
    }
}
struct KSeg { const bf16* K; long ks; const bf16* Vt; long vs; int k_lo, k_hi; int win; };
template <int NMAP, int DV>
struct AttnState { f32x16 o[NMAP][DV / 32]; float m[NMAP], l[NMAP]; };

template <int NMAP, int DV, bool QL>
__device__ __forceinline__ void attn_seg(AttnState<NMAP, DV>& st, const bf16x8 (&qf)[NMAP][4], const LAS bf16x8* ql, const KSeg& sg, int q0, int lane) {
    const int r = lane & 31, h = lane >> 5;
    constexpr float SC = 0.125f * 1.4426950408889634f;
    for (int k0 = sg.k_lo; k0 < sg.k_hi; k0 += 32) {
        bf16x8 pf[NMAP][2];
#pragma unroll
        for (int mp = 0; mp < NMAP; ++mp) {
            const bf16* kp = sg.K + (long)(k0 + r) * sg.ks + mp * 64 + 8 * h;
            f32x16 s;
#pragma unroll
            for (int i = 0; i < 16; ++i) s[i] = 0.f;
#pragma unroll
            for (int ks = 0; ks < 4; ++ks) { const bf16x8 kf = *(const bf16x8*)(kp + 16 * ks); const bf16x8 qv = QL ? ql[(mp * 4 + ks) * 64 + lane] : qf[mp][ks]; s = MFMA32(kf, qv, s); }
            float mx = -INFINITY;
#pragma unroll
            for (int i = 0; i < 16; ++i) { float v = s[i] * SC;
                if (sg.win) { const int d = k0 + crow(i, h) - (q0 + r); if (d > 128 || d < -128) v = -INFINITY; }
                s[i] = v; mx = fmaxf(mx, v); }
            mx = fmaxf(mx, __shfl_xor(mx, 32));
            const float mn = fmaxf(st.m[mp], mx); const float ms = (mn == -INFINITY) ? 0.f : mn;
            const float alpha = __builtin_amdgcn_exp2f(st.m[mp] - ms);
            st.m[mp] = mn;
            float ps = 0.f;
#pragma unroll
            for (int i = 0; i < 16; ++i) { s[i] = __builtin_amdgcn_exp2f(s[i] - ms); ps += s[i]; }
            st.l[mp] = st.l[mp] * alpha + ps;
#pragma unroll
            for (int dt = 0; dt < DV / 32; ++dt)
#pragma unroll
                for (int i = 0; i < 16; ++i) st.o[mp][dt][i] *= alpha;
#pragma unroll
            for (int s2 = 0; s2 < 2; ++s2) { u32x4 w; w.x = pk2(s[8 * s2], s[8 * s2 + 1]); w.y = pk2(s[8 * s2 + 2], s[8 * s2 + 3]); w.z = pk2(s[8 * s2 + 4], s[8 * s2 + 5]); w.w = pk2(s[8 * s2 + 6], s[8 * s2 + 7]);
                pf[mp][s2] = __builtin_bit_cast(bf16x8, w); }
            asm volatile("" ::: "memory");
        }
#pragma unroll
        for (int dt = 0; dt < DV / 32; ++dt) {
            const bf16* vp = sg.Vt + (long)(dt * 32 + r) * sg.vs + k0 + 4 * h;
#pragma unroll
            for (int s2 = 0; s2 < 2; ++s2) {
                const s16x4 lo = *(const s16x4*)(vp + 16 * s2), hi = *(const s16x4*)(vp + 16 * s2 + 8);
                const bf16x8 vf = __builtin_shufflevector(lo, hi, 0, 1, 2, 3, 4, 5, 6, 7);
#pragma unroll
                for (int mp = 0; mp < NMAP; ++mp) st.o[mp][dt] = MFMA32(vf, pf[mp][s2], st.o[mp][dt]);
            }
            asm volatile("" ::: "memory");
        }
    }
}
template <int NMAP, int DV>
__device__ __forceinline__ void attn_init(AttnState<NMAP, DV>& st) {
#pragma unroll
    for (int mp = 0; mp < NMAP; ++mp) { st.m[mp] = -INFINITY; st.l[mp] = 0.f;
#pragma unroll
        for (int dt = 0; dt < DV / 32; ++dt)
#pragma unroll
            for (int i = 0; i < 16; ++i) st.o[mp][dt][i] = 0.f; }
}
__device__ __forceinline__ void load_q(bf16x8 (&qf)[4], const bf16* q, int lane) {
#pragma unroll
    for (int ks = 0; ks < 4; ++ks) qf[ks] = *(const bf16x8*)(q + 16 * ks + 8 * (lane >> 5));
}
__device__ __forceinline__ bf16x8 pack8a(const f32x16& x, int s2) {
    u32x4 w; w.x = pk2(x[8 * s2], x[8 * s2 + 1]); w.y = pk2(x[8 * s2 + 2], x[8 * s2 + 3]); w.z = pk2(x[8 * s2 + 4], x[8 * s2 + 5]); w.w = pk2(x[8 * s2 + 6], x[8 * s2 + 7]);
    return __builtin_bit_cast(bf16x8, w);
}
__device__ __forceinline__ void attn_segA(AttnState<1, 64>& st, const bf16x8 (&qf)[4], const KSeg& sg, int q0, int lane) {
    const int r = lane & 31, h = lane >> 5;
    constexpr float SC = 0.125f * 1.4426950408889634f;
    if (sg.k_lo >= sg.k_hi) return;
    bf16x8 kf[4]; s16x4 vlo[2][2], vhi[2][2];
#define A_LOAD(K0) do { const bf16* kp_ = sg.K + (long)((K0) + r) * sg.ks + 8 * h; \
        _Pragma("unroll") for (int ks = 0; ks < 4; ++ks) kf[ks] = *(const bf16x8*)(kp_ + 16 * ks); \
        _Pragma("unroll") for (int dt = 0; dt < 2; ++dt) { const bf16* vp_ = sg.Vt + (long)(dt * 32 + r) * sg.vs + (K0) + 4 * h; \
            _Pragma("unroll") for (int s2 = 0; s2 < 2; ++s2) { vlo[dt][s2] = *(const s16x4*)(vp_ + 16 * s2); vhi[dt][s2] = *(const s16x4*)(vp_ + 16 * s2 + 8); } } } while (0)
    A_LOAD(sg.k_lo);
    for (int k0 = sg.k_lo; k0 < sg.k_hi; k0 += 32) {
        bf16x8 kc[4]; s16x4 cl[2][2], ch[2][2];
#pragma unroll
        for (int ks = 0; ks < 4; ++ks) kc[ks] = kf[ks];
#pragma unroll
        for (int dt = 0; dt < 2; ++dt)
#pragma unroll
            for (int s2 = 0; s2 < 2; ++s2) { cl[dt][s2] = vlo[dt][s2]; ch[dt][s2] = vhi[dt][s2]; }
        if (k0 + 32 < sg.k_hi) A_LOAD(k0 + 32);
        f32x16 s;
#pragma unroll
        for (int i = 0; i < 16; ++i) s[i] = 0.f;
#pragma unroll
        for (int ks = 0; ks < 4; ++ks) s = MFMA32(kc[ks], qf[ks], s);
        float mx = -INFINITY;
#pragma unroll
        for (int i = 0; i < 16; ++i) { float v = s[i] * SC;
            if (sg.win) { const int d = k0 + crow(i, h) - (q0 + r); if (d > 128 || d < -128) v = -INFINITY; }
            s[i] = v; mx = fmaxf(mx, v); }
        mx = fmaxf(mx, __shfl_xor(mx, 32));
        const float mn = fmaxf(st.m[0], mx); const float ms = (mn == -INFINITY) ? 0.f : mn;
        const float alpha = __builtin_amdgcn_exp2f(st.m[0] - ms);
        st.m[0] = mn;
        float ps = 0.f;
#pragma unroll
        for (int i = 0; i < 16; ++i) { s[i] = __builtin_amdgcn_exp2f(s[i] - ms); ps += s[i]; }
        st.l[0] = st.l[0] * alpha + ps;
#pragma unroll
        for (int dt = 0; dt < 2; ++dt)
#pragma unroll
            for (int i = 0; i < 16; ++i) st.o[0][dt][i] *= alpha;
        const bf16x8 p0 = pack8a(s, 0), p1 = pack8a(s, 1);
#pragma unroll
        for (int dt = 0; dt < 2; ++dt) {
            st.o[0][dt] = MFMA32(__builtin_shufflevector(cl[dt][0], ch[dt][0], 0, 1, 2, 3, 4, 5, 6, 7), p0, st.o[0][dt]);
            st.o[0][dt] = MFMA32(__builtin_shufflevector(cl[dt][1], ch[dt][1], 0, 1, 2, 3, 4, 5, 6, 7), p1, st.o[0][dt]);
        }
    }
#undef A_LOAD
}
__device__ __forceinline__ void attnA_phase(Frame& F, int jl) {
    const bf16* P = (const bf16*)(F.ws + WS_G); const bf16* VtA = (const bf16*)(F.ws + WS_G + G_VTA);
    bf16* O = (bf16*)(F.ws + WS_H);
    const int lane = F.lane, r = lane & 31, h = lane >> 5;
    constexpr int NU_L = 8 * 8 * 128, NU_P = 32 * 8 * 8;
    const bool part = (F.G == 256); const int xcd = F.bid & 7;
    unsigned* ctr = (unsigned*)F.ws + 3600 + 16 * (jl * 8 + (part ? xcd : 0));
    const int nunits = part ? 1280 : NU_L + NU_P;
    for (;;) {
        unsigned ug = 0; if (lane == 0) ug = atomicAdd(ctr, 1u);
        const int u = (int)__builtin_amdgcn_readfirstlane(ug);
        if (u >= nunits) break;
        int m0, T, head, qb, b; bool latent;
        if (part) { latent = u < 1024;
            if (latent) { b = xcd; head = u >> 7; qb = u & 127; m0 = MPR + b * TL; T = TL; }
            else { const int v = u - 1024; b = 4 * xcd + (v >> 6); head = (v >> 3) & 7; qb = v & 7; m0 = b * TP; T = TP; } }
        else { latent = u < NU_L;
            if (latent) { b = u >> 10; head = (u >> 7) & 7; qb = u & 127; m0 = MPR + b * TL; T = TL; }
            else { const int v = u - NU_L; b = v >> 6; head = (v >> 3) & 7; qb = v & 7; m0 = b * TP; T = TP; } }
        const int q0 = qb * 32, kvh = head >> 2;
        bf16x8 qf[1][4]; load_q(qf[0], P + (size_t)(m0 + q0 + r) * PLD_AB + head * 64, lane);
        AttnState<1, 64> st; attn_init(st);
        KSeg s1; s1.K = P + (size_t)m0 * PLD_AB + 512 + kvh * 64; s1.ks = PLD_AB; s1.Vt = VtA + (size_t)(kvh * 64) * MTOK + m0; s1.vs = MTOK;
        if (latent) {
            KSeg s0; s0.K = (const bf16*)(F.ws + WS_KAC) + (size_t)(b * 2 + jl) * 512 * 128 + kvh * 64; s0.ks = 128;
            s0.Vt = (const bf16*)(F.ws + WS_VAC) + (size_t)(b * 2 + jl) * 128 * 512 + (size_t)(kvh * 64) * 512; s0.vs = 512; s0.k_lo = 0; s0.k_hi = 512; s0.win = 0;
            attn_segA(st, qf[0], s0, q0, lane);
            s1.k_lo = q0 - 128 < 0 ? 0 : q0 - 128; s1.k_hi = q0 + 160 > T ? T : q0 + 160; s1.win = 1;
        } else { s1.k_lo = 0; s1.k_hi = T; s1.win = 0; }
        attn_segA(st, qf[0], s1, q0, lane);
        float l = st.l[0] + __shfl_xor(st.l[0], 32);
        l += __builtin_amdgcn_exp2f(F.in[I_SINK][jl * 8 + head] * 1.4426950408889634f - st.m[0]);
        const float rl = 1.0f / l;
        bf16* op = O + (size_t)(m0 + q0 + r) * 1024 + head * 64;
#pragma unroll
        for (int dt = 0; dt < 2; ++dt)
#pragma unroll
            for (int g = 0; g < 4; ++g) { const int d = dt * 32 + 8 * g + 4 * h;
                *(u32x2*)(op + d) = (u32x2){pk2(st.o[0][dt][4 * g] * rl, st.o[0][dt][4 * g + 1] * rl), pk2(st.o[0][dt][4 * g + 2] * rl, st.o[0][dt][4 * g + 3] * rl)}; }
    }
}
__device__ __forceinline__ void attnC_phase(Frame& F, int jl, int layer) {
    const bf16* P = (const bf16*)(F.ws + WS_G); const bf16* VtC = (const bf16*)(F.ws + WS_G + G_VTC);
    bf16* O = (bf16*)(F.ws + WS_H);
    const int lane = F.lane, r = lane & 31, h = lane >> 5;
    const int wk = F.bid * 8 + F.wave, nwk = F.G * 8;
    const float lam_init = 0.8f - 0.6f * expf(-0.3f * (float)layer);
    const float d1 = wave_sum(F.in[I_LQ1][jl * 64 + lane] * F.in[I_LK1][jl * 64 + lane]), d2 = wave_sum(F.in[I_LQ2][jl * 64 + lane] * F.in[I_LK2][jl * 64 + lane]);
    const float lam = expf(d1) - expf(d2) + lam_init;
    const float* subln = F.in[I_SUBLN] + jl * 128;
    LAS bf16x8* ql = (LAS bf16x8*)(F.lds + F.wave * 8192);
    constexpr int NU_L = 8 * 8 * 128, NU_P = 32 * 8 * 8;
    for (int u = wk; u < NU_L + NU_P; u += nwk) {
        int m0, T, head, qb, b; bool latent = u < NU_L;
        if (latent) { b = u >> 10; head = (u >> 7) & 7; qb = u & 127; m0 = MPR + b * TL; T = TL; }
        else { const int v = u - NU_L; b = v >> 6; head = (v >> 3) & 7; qb = v & 7; m0 = b * TP; T = TP; }
        const int q0 = qb * 32;
        bf16x8 qf[2][4];
        { bf16x8 qt[4]; load_q(qt, P + (size_t)(m0 + q0 + r) * PLD_C + head * 128, lane);
#pragma unroll
          for (int ks = 0; ks < 4; ++ks) ql[ks * 64 + lane] = qt[ks];
          load_q(qt, P + (size_t)(m0 + q0 + r) * PLD_C + head * 128 + 64, lane);
#pragma unroll
          for (int ks = 0; ks < 4; ++ks) ql[(4 + ks) * 64 + lane] = qt[ks]; }
        asm volatile("s_waitcnt lgkmcnt(0)" ::: "memory");
        AttnState<2, 128> st; attn_init(st);
        if (latent) {
            KSeg s0; s0.K = (const bf16*)(F.ws + WS_KCC) + (size_t)(b * 2 + jl) * 512 * 1024 + head * 128; s0.ks = 1024;
            s0.Vt = (const bf16*)(F.ws + WS_VCC) + (size_t)(b * 2 + jl) * 1024 * 512 + (size_t)(head * 128) * 512; s0.vs = 512; s0.k_lo = 0; s0.k_hi = 512; s0.win = 0;
            attn_seg<2, 128, true>(st, qf, ql, s0, q0, lane);
        }
        KSeg s1; s1.K = P + (size_t)m0 * PLD_C + 1024 + head * 128; s1.ks = PLD_C; s1.Vt = VtC + (size_t)(head * 128) * MTOK + m0; s1.vs = MTOK; s1.k_lo = 0; s1.k_hi = T; s1.win = 0;
        attn_seg<2, 128, true>(st, qf, ql, s1, q0, lane);
        const float l1 = st.l[0] + __shfl_xor(st.l[0], 32), l2 = st.l[1] + __shfl_xor(st.l[1], 32);
        const float r1 = 1.0f / l1, r2 = lam / l2;
        float ss = 0.f;
#pragma unroll
        for (int dt = 0; dt < 4; ++dt)
#pragma unroll
            for (int i = 0; i < 16; ++i) { const float v = st.o[0][dt][i] * r1 - st.o[1][dt][i] * r2; st.o[0][dt][i] = v; ss += v * v; }
        ss += __shfl_xor(ss, 32);
        const float rs = (1.0f / sqrtf(ss * (1.0f / 128.0f) + 1e-5f)) * (1.0f - lam_init);
        bf16* op = O + (size_t)(m0 + q0 + r) * 1024 + head * 128;
#pragma unroll
        for (int dt = 0; dt < 4; ++dt)
#pragma unroll
            for (int g = 0; g < 4; ++g) { const int d = dt * 32 + 8 * g + 4 * h; const f32x4 w = *(const f32x4*)(subln + d);
                *(u32x2*)(op + d) = (u32x2){pk2(st.o[0][dt][4 * g] * rs * w[0], st.o[0][dt][4 * g + 1] * rs * w[1]), pk2(st.o[0][dt][4 * g + 2] * rs * w[2], st.o[0][dt][4 * g + 3] * rs * w[3])}; }
    }
}
__device__ __forceinline__ bf16x8 pack8(const f32x16& x, int s2) {
    u32x4 w; w.x = pk2(x[8 * s2], x[8 * s2 + 1]); w.y = pk2(x[8 * s2 + 2], x[8 * s2 + 3]); w.z = pk2(x[8 * s2 + 4], x[8 * s2 + 5]); w.w = pk2(x[8 * s2 + 6], x[8 * s2 + 7]);
    return __builtin_bit_cast(bf16x8, w);
}
constexpr int KP = 136, VP = 36;
constexpr int C2_Q = 0, C2_K = 65536, C2_V = C2_K + 2 * 32 * KP * 2, C2_END = C2_V + 2 * 128 * VP * 2;
static_assert(C2_END <= 147456, "attnC2 LDS");
__device__ __forceinline__ void attnC2_phase(Frame& F, int jl, int layer) {
    const bf16* P = (const bf16*)(F.ws + WS_G); const bf16* VtC = (const bf16*)(F.ws + WS_G + G_VTC);
    bf16* O = (bf16*)(F.ws + WS_H);
    const float lam_init = 0.8f - 0.6f * expf(-0.3f * (float)layer);
    const float d1 = wave_sum(F.in[I_LQ1][jl * 64 + F.lane] * F.in[I_LK1][jl * 64 + F.lane]), d2 = wave_sum(F.in[I_LQ2][jl * 64 + F.lane] * F.in[I_LK2][jl * 64 + F.lane]);
    const float lam = expf(d1) - expf(d2) + lam_init;
    const float* subln = F.in[I_SUBLN] + jl * 128;
    LAS bf16x8* ql = (LAS bf16x8*)(F.lds + C2_Q + F.wave * 8192);
    constexpr float SC = 0.125f * 1.4426950408889634f;
    for (int u0 = F.bid; u0 < 1280; u0 += F.G) {
        int u = u0;
        if (F.G == 256 && u0 < 1024) { const int k = u0 >> 8, xcd = F.bid & 7, slot = F.bid >> 3; u = ((k * 16 + xcd * 2 + (slot >> 4)) << 4) + (slot & 15); }
        int lane = F.lane; asm volatile("" : "+v"(lane));
        const int tid = F.wave * 64 + lane, r = lane & 31, h = lane >> 5;
        int m0, T, head, b, qb; const bool latent = u < 1024;
        if (latent) { b = u >> 7; head = (u >> 4) & 7; qb = u & 15; m0 = MPR + b * TL; T = TL; } else { const int v = u - 1024; b = v >> 3; head = v & 7; qb = 0; m0 = b * TP; T = TP; }
        const int q0 = qb * 256 + F.wave * 32;
        bf16x8 qf0[4];
        load_q(qf0, P + (size_t)(m0 + q0 + r) * PLD_C + head * 128, lane);
        { bf16x8 qt[4]; load_q(qt, P + (size_t)(m0 + q0 + r) * PLD_C + head * 128 + 64, lane);
#pragma unroll
          for (int ks = 0; ks < 4; ++ks) ql[ks * 64 + lane] = qt[ks]; }
        AttnState<2, 128> st; attn_init(st);
        const int nctx = latent ? 16 : 0, ntile = nctx + T / 32;
        const bf16* kc = (const bf16*)(F.ws + WS_KCC) + (size_t)(b * 2 + jl) * 512 * 1024 + head * 128 + (size_t)(tid >> 4) * 1024 + (tid & 15) * 8;
        const bf16* vc = (const bf16*)(F.ws + WS_VCC) + (size_t)(b * 2 + jl) * 1024 * 512 + (size_t)(head * 128 + (tid >> 2)) * 512 + (tid & 3) * 8;
        const bf16* kl = P + (size_t)m0 * PLD_C + 1024 + head * 128 + (size_t)(tid >> 4) * PLD_C + (tid & 15) * 8;
        const bf16* vl = VtC + (size_t)(head * 128 + (tid >> 2)) * MTOK + m0 + (tid & 3) * 8;
        const int kw = (tid >> 4) * KP + (tid & 15) * 8, vw = (tid >> 2) * VP + (tid & 3) * 8;
        u32x4 kreg, vreg;
#define C2_LOAD(ti) do { if ((ti) < nctx) { kreg = *(const u32x4*)(kc + (size_t)(ti) * 32 * 1024); vreg = *(const u32x4*)(vc + (ti) * 32); } \
                         else { const int k0_ = ((ti) - nctx) * 32; kreg = *(const u32x4*)(kl + (size_t)k0_ * PLD_C); vreg = *(const u32x4*)(vl + k0_); } } while (0)
#define C2_STORE(bufi) do { *(LAS u32x4*)((LAS bf16*)(F.lds + C2_K) + (bufi) * 32 * KP + kw) = kreg; *(LAS u32x2*)((LAS bf16*)(F.lds + C2_V) + (bufi) * 128 * VP + vw) = (u32x2){vreg.x, vreg.y}; *(LAS u32x2*)((LAS bf16*)(F.lds + C2_V) + (bufi) * 128 * VP + vw + 4) = (u32x2){vreg.z, vreg.w}; } while (0)
        C2_LOAD(0); C2_STORE(0);
        asm volatile("s_waitcnt vmcnt(0) lgkmcnt(0)" ::: "memory"); __builtin_amdgcn_s_barrier(); asm volatile("" ::: "memory");
        for (int ti = 0; ti < ntile; ++ti) {
            const bool more = ti + 1 < ntile;
            if (more) C2_LOAD(ti + 1);
            const LAS bf16* Kb = (const LAS bf16*)(F.lds + C2_K) + (ti & 1) * 32 * KP; const LAS bf16* Vb = (const LAS bf16*)(F.lds + C2_V) + (ti & 1) * 128 * VP;
            bf16x8 pf[2][2];
#pragma unroll
            for (int mp = 0; mp < 2; ++mp) {
                f32x16 s;
#pragma unroll
                for (int i = 0; i < 16; ++i) s[i] = 0.f;
#pragma unroll
                for (int ks = 0; ks < 4; ++ks) { const bf16x8 kf = *(const LAS bf16x8*)(Kb + r * KP + mp * 64 + 16 * ks + 8 * h); s = MFMA32(kf, mp == 0 ? qf0[ks] : ql[ks * 64 + lane], s); }
                float mx = -INFINITY;
#pragma unroll
                for (int i = 0; i < 16; ++i) mx = fmaxf(mx, s[i]);
                mx = fmaxf(mx, __shfl_xor(mx, 32)) * SC;
                const float mn = (mx > st.m[mp] + 8.0f) ? mx : st.m[mp];
                const float alpha = __builtin_amdgcn_exp2f(st.m[mp] - mn);
                st.m[mp] = mn;
                float ps = 0.f;
#pragma unroll
                for (int i = 0; i < 16; ++i) { s[i] = __builtin_amdgcn_exp2f(__builtin_fmaf(s[i], SC, -mn)); ps += s[i]; }
                st.l[mp] = st.l[mp] * alpha + ps;
                if (__any(alpha != 1.0f)) {
#pragma unroll
                    for (int dt = 0; dt < 4; ++dt)
#pragma unroll
                        for (int i = 0; i < 16; ++i) st.o[mp][dt][i] *= alpha; }
                pf[mp][0] = pack8(s, 0); pf[mp][1] = pack8(s, 1);
                asm volatile("" ::: "memory");
            }
#pragma unroll
            for (int dt = 0; dt < 4; ++dt) {
#pragma unroll
                for (int s2 = 0; s2 < 2; ++s2) {
                    const LAS bf16* vp = Vb + (dt * 32 + r) * VP + 16 * s2 + 4 * h;
                    const s16x4 lo = *(const LAS s16x4*)vp, hi = *(const LAS s16x4*)(vp + 8);
                    const bf16x8 vf = __builtin_shufflevector(lo, hi, 0, 1, 2, 3, 4, 5, 6, 7);
                    st.o[0][dt] = MFMA32(vf, pf[0][s2], st.o[0][dt]); st.o[1][dt] = MFMA32(vf, pf[1][s2], st.o[1][dt]);
                }
                asm volatile("" ::: "memory");
            }
            if (more) C2_STORE((ti + 1) & 1);
            asm volatile("s_waitcnt vmcnt(0) lgkmcnt(0)" ::: "memory"); __builtin_amdgcn_s_barrier(); asm volatile("" ::: "memory");
        }
#undef C2_LOAD
#undef C2_STORE
        const float l1 = st.l[0] + __shfl_xor(st.l[0], 32), l2 = st.l[1] + __shfl_xor(st.l[1], 32);
        const float r1 = 1.0f / l1, r2 = lam / l2;
        float ss = 0.f;
#pragma unroll
        for (int dt = 0; dt < 4; ++dt)
#pragma unroll
            for (int i = 0; i < 16; ++i) { const float v = st.o[0][dt][i] * r1 - st.o[1][dt][i] * r2; st.o[0][dt][i] = v; ss += v * v; }
        ss += __shfl_xor(ss, 32);
        const float rs = (1.0f / sqrtf(ss * (1.0f / 128.0f) + 1e-5f)) * (1.0f - lam_init);
        bf16* op = O + (size_t)(m0 + q0 + r) * 1024 + head * 128;
#pragma unroll
        for (int dt = 0; dt < 4; ++dt)
#pragma unroll
            for (int g = 0; g < 4; ++g) { const int d = dt * 32 + 8 * g + 4 * h; const f32x4 w = *(const f32x4*)(subln + d);
                *(u32x2*)(op + d) = (u32x2){pk2(st.o[0][dt][4 * g] * rs * w[0], st.o[0][dt][4 * g + 1] * rs * w[1]), pk2(st.o[0][dt][4 * g + 2] * rs * w[2], st.o[0][dt][4 * g + 3] * rs * w[3])}; }
    }
}
__device__ __forceinline__ float shift3(const bf16* p, long pitch, bool hp, bool hn, float mup, float mun) {
    const float c = bf2f(p[0]); const float pv = hp ? bf2f(p[-pitch]) : 0.f; const float nx = hn ? bf2f(p[pitch]) : 0.f;
    return c + mup * (pv - c) + mun * (nx - c);
}
__device__ __forceinline__ float sigmoid_f(float x) { return __builtin_amdgcn_rcpf(1.0f + __builtin_amdgcn_exp2f(-1.4426950408889634f * x)); }
__device__ __forceinline__ float tanh_f(float x) { const float e = __builtin_amdgcn_exp2f(2.8853900817779268f * fminf(fmaxf(x, -15.f), 15.f)); return 1.0f - 2.0f * __builtin_amdgcn_rcpf(e + 1.0f); }
__device__ __forceinline__ void rwkv_scan_phase(Frame& F, int jl) {
    const int it = F.wave * F.G + F.bid;
    if (F.wave >= 3 || it >= 640) return;
    LAS float* vec = (LAS float*)(F.lds + F.wave * 20480);
    LAS float* twl = vec + 6 * 8 * 64;
    LAS float* adl = twl + 8 * 64;
    int b, h, d, T, m0; const bool latent = it < 128;
    if (latent) { b = it >> 4; h = (it >> 1) & 7; d = it & 1; T = TL; m0 = MPR + b * TL; }
    else { const int p = it - 128; b = p >> 4; h = (p >> 1) & 7; d = p & 1; T = TP; m0 = b * TP; }
    const bf16* P = (const bf16*)(F.ws + WS_G);
    bf16* Yd = (bf16*)(F.ws + WS_Y) + (size_t)d * MTOK * 512;
    float* BC = (float*)(F.ws + WS_BC) + (size_t)d * MTOK * 8;
    const int lane = F.lane, col = h * 64 + lane;
    const float* mup = F.in[I_MUP] + jl * 1920; const float* mun = F.in[I_MUN] + jl * 1920;
    const float mp_r = mup[col], mn_r = mun[col], mp_k = mup[512 + col], mn_k = mun[512 + col], mp_v = mup[1024 + col], mn_v = mun[1024 + col];
    const float mp_w = mup[1536 + d * 64 + lane], mn_w = mun[1536 + d * 64 + lane], mp_a = mup[1664 + d * 64 + lane], mn_a = mun[1664 + d * 64 + lane];
    const float w0 = F.in[I_BW0][(jl * 2 + d) * 512 + col], a0 = F.in[I_BA0][(jl * 2 + d) * 512 + col];
    const float kk_c = F.in[I_BKK][jl * 512 + col], ka_c = F.in[I_BKA][jl * 512 + col], rk_c = F.in[I_BRK][jl * 512 + col];
    const float* W2 = F.in[I_BW2] + (size_t)(jl * 2 + d) * 64 * 512 + col; const float* A2 = F.in[I_BA2] + (size_t)(jl * 2 + d) * 64 * 512 + col;
    float S[64];
    if (latent) { const f32x4* sp = (const f32x4*)(F.in[I_SB] + ((size_t)(((b * 2 + jl) * 2 + d) * 8 + h) * 64 + lane) * 64);
#pragma unroll
        for (int j4 = 0; j4 < 16; ++j4) { const f32x4 v = sp[j4]; S[4 * j4] = v.x; S[4 * j4 + 1] = v.y; S[4 * j4 + 2] = v.z; S[4 * j4 + 3] = v.w; } }
    else {
#pragma unroll
        for (int j = 0; j < 64; ++j) S[j] = 0.f; }
    for (int blk = 0; blk < T / 8; ++blk) {
        float r_[8], k_[8], v_[8], kk[8];
#pragma unroll
        for (int tt = 0; tt < 8; ++tt) {
            const int s = blk * 8 + tt, t = d ? T - 1 - s : s; const bool hp = t > 0, hn = t < T - 1;
            const bf16* pr = P + (size_t)(m0 + t) * PLD_AB + 768;
            r_[tt] = shift3(pr + col, PLD_AB, hp, hn, mp_r, mn_r); k_[tt] = shift3(pr + 512 + col, PLD_AB, hp, hn, mp_k, mn_k); v_[tt] = shift3(pr + 1024 + col, PLD_AB, hp, hn, mp_v, mn_v);
            const float wd = shift3(pr + 1536 + d * 64 + lane, PLD_AB, hp, hn, mp_w, mn_w), ad = shift3(pr + 1664 + d * 64 + lane, PLD_AB, hp, hn, mp_a, mn_a);
            twl[tt * 64 + lane] = tanhf(wd); adl[tt * 64 + lane] = ad;
            const float kv = k_[tt] * kk_c; const float nrm = sqrtf(wave_sum(kv * kv)); kk[tt] = kv / fmaxf(nrm, 1e-12f);
        }
        asm volatile("s_waitcnt lgkmcnt(0)" ::: "memory");
        float aw[8], aa[8];
#pragma unroll
        for (int tt = 0; tt < 8; ++tt) { aw[tt] = 0.f; aa[tt] = 0.f; }
        for (int l4 = 0; l4 < 16; ++l4) {
            float wv[4], av[4];
#pragma unroll
            for (int q = 0; q < 4; ++q) { wv[q] = W2[(size_t)(4 * l4 + q) * 512]; av[q] = A2[(size_t)(4 * l4 + q) * 512]; }
#pragma unroll
            for (int tt = 0; tt < 8; ++tt) { const f32x4 t4 = *(const LAS f32x4*)(twl + tt * 64 + 4 * l4), a4 = *(const LAS f32x4*)(adl + tt * 64 + 4 * l4);
                aw[tt] += t4.x * wv[0] + t4.y * wv[1] + t4.z * wv[2] + t4.w * wv[3]; aa[tt] += a4.x * av[0] + a4.y * av[1] + a4.z * av[2] + a4.w * av[3]; }
        }
#pragma unroll
        for (int tt = 0; tt < 8; ++tt) {
            const int s = blk * 8 + tt, t = d ? T - 1 - s : s;
            const float x = -(w0 + aw[tt]); const float sp = fmaxf(x, 0.f) + log1pf(__expf(-fabsf(x)));
            const float wlog = -sp - 0.5f; const float dec = __expf(-__expf(wlog));
            const float a = sigmoid_f(a0 + aa[tt]); const float kd = k_[tt] * (1.0f + (a - 1.0f) * ka_c); const float bb = kk[tt] * a;
            const float bon = wave_sum(r_[tt] * kd * rk_c); if (lane == 0) BC[(size_t)(m0 + t) * 8 + h] = bon;
            vec[(0 * 8 + tt) * 64 + lane] = dec; vec[(1 * 8 + tt) * 64 + lane] = kk[tt]; vec[(2 * 8 + tt) * 64 + lane] = bb;
            vec[(3 * 8 + tt) * 64 + lane] = kd; vec[(4 * 8 + tt) * 64 + lane] = r_[tt]; vec[(5 * 8 + tt) * 64 + lane] = v_[tt];
        }
        asm volatile("s_waitcnt lgkmcnt(0)" ::: "memory");
#pragma unroll 1
        for (int tt = 0; tt < 8; ++tt) {
            const int s = blk * 8 + tt, t = d ? T - 1 - s : s;
            const float vi = vec[(5 * 8 + tt) * 64 + lane];
            float sa = 0.f;
#pragma unroll
            for (int j4 = 0; j4 < 16; ++j4) { const f32x4 k4 = *(const LAS f32x4*)(vec + (1 * 8 + tt) * 64 + 4 * j4);
                sa += S[4 * j4] * k4.x + S[4 * j4 + 1] * k4.y + S[4 * j4 + 2] * k4.z + S[4 * j4 + 3] * k4.w; }
            float y = 0.f;
#pragma unroll
            for (int j4 = 0; j4 < 16; ++j4) {
                const f32x4 w4 = *(const LAS f32x4*)(vec + (0 * 8 + tt) * 64 + 4 * j4), b4 = *(const LAS f32x4*)(vec + (2 * 8 + tt) * 64 + 4 * j4);
                const f32x4 k4 = *(const LAS f32x4*)(vec + (3 * 8 + tt) * 64 + 4 * j4), r4 = *(const LAS f32x4*)(vec + (4 * 8 + tt) * 64 + 4 * j4);
#pragma unroll
                for (int q = 0; q < 4; ++q) { float sv = S[4 * j4 + q]; sv = sv * w4[q] - sa * b4[q] + vi * k4[q]; S[4 * j4 + q] = sv; y += sv * r4[q]; }
            }
            Yd[(size_t)(m0 + t) * 512 + col] = (bf16)f2bf(y);
        }
        asm volatile("s_waitcnt lgkmcnt(0)" ::: "memory");
    }
    if (!latent) { f32x4* op = (f32x4*)(F.out + O_BW + ((size_t)(((b * 2 + jl) * 2 + d) * 8 + h) * 64 + lane) * 64);
#pragma unroll
        for (int j4 = 0; j4 < 16; ++j4) op[j4] = (f32x4){S[4 * j4], S[4 * j4 + 1], S[4 * j4 + 2], S[4 * j4 + 3]}; }
}
__device__ __forceinline__ void rwkv_post_phase(Frame& F, int jl) {
    LAS float* sg = (LAS float*)(F.lds + F.wave * 4096);
    const bf16* P = (const bf16*)(F.ws + WS_G); const bf16* Y0 = (const bf16*)(F.ws + WS_Y); const bf16* Y1 = Y0 + (size_t)MTOK * 512;
    const float* BC = (const float*)(F.ws + WS_BC); bf16* O = (bf16*)(F.ws + WS_H);
    const float* g2 = F.in[I_BG2] + (size_t)jl * 128 * 512; const float* mup = F.in[I_MUP] + jl * 1920; const float* mun = F.in[I_MUN] + jl * 1920;
    const int lane = F.lane, c0 = 8 * lane, head = lane >> 3;
    const int gw = F.bid * 8 + F.wave, NGW = F.G * 8;
    float gnw[8], gnb[8], mpv[8], mnv[8];
#pragma unroll
    for (int i = 0; i < 8; ++i) { gnw[i] = F.in[I_GNW][jl * 512 + c0 + i]; gnb[i] = F.in[I_GNB][jl * 512 + c0 + i]; mpv[i] = mup[1024 + c0 + i]; mnv[i] = mun[1024 + c0 + i]; }
    const float mpg0 = mup[1792 + lane], mng0 = mun[1792 + lane], mpg1 = mup[1856 + lane], mng1 = mun[1856 + lane];
    for (int grp = gw; grp < MTOK / 8; grp += NGW) {
#pragma unroll
        for (int tt = 0; tt < 8; ++tt) { const int m = grp * 8 + tt; const int t = m < MPR ? (m & 255) : ((m - MPR) & 4095); const int T = m < MPR ? TP : TL;
            const bf16* pr = P + (size_t)m * PLD_AB + 768 + 1792;
            sg[tt * 128 + lane] = sigmoid_f(shift3(pr + lane, PLD_AB, t > 0, t < T - 1, mpg0, mng0)); sg[tt * 128 + 64 + lane] = sigmoid_f(shift3(pr + 64 + lane, PLD_AB, t > 0, t < T - 1, mpg1, mng1)); }
        asm volatile("s_waitcnt lgkmcnt(0)" ::: "memory");
        float acc[8][8];
#pragma unroll
        for (int tt = 0; tt < 8; ++tt)
#pragma unroll
            for (int i = 0; i < 8; ++i) acc[tt][i] = 0.f;
#pragma unroll 2
        for (int l4 = 0; l4 < 32; ++l4) {
            f32x4 s4[8];
#pragma unroll
            for (int tt = 0; tt < 8; ++tt) s4[tt] = *(const LAS f32x4*)(sg + tt * 128 + 4 * l4);
#pragma unroll
            for (int q = 0; q < 4; ++q) { const f32x4 ga = *(const f32x4*)(g2 + (size_t)(4 * l4 + q) * 512 + c0), gb = *(const f32x4*)(g2 + (size_t)(4 * l4 + q) * 512 + c0 + 4);
#pragma unroll
                for (int tt = 0; tt < 8; ++tt) { const float s = s4[tt][q];
#pragma unroll
                    for (int i = 0; i < 4; ++i) { acc[tt][i] += s * ga[i]; acc[tt][4 + i] += s * gb[i]; } } }
        }
#pragma unroll
        for (int tt = 0; tt < 8; ++tt) { const int m = grp * 8 + tt; const int t = m < MPR ? (m & 255) : ((m - MPR) & 4095); const int T = m < MPR ? TP : TL;
            const bf16x8 ya = *(const bf16x8*)(Y0 + (size_t)m * 512 + c0), yb = *(const bf16x8*)(Y1 + (size_t)m * 512 + c0);
            float y[8]; float sm = 0.f;
#pragma unroll
            for (int i = 0; i < 8; ++i) { y[i] = bf2f((unsigned short)ya[i]) + bf2f((unsigned short)yb[i]); sm += y[i]; }
            sm += __shfl_xor(sm, 1); sm += __shfl_xor(sm, 2); sm += __shfl_xor(sm, 4);
            const float mu = sm * (1.0f / 64.0f); float vs = 0.f;
#pragma unroll
            for (int i = 0; i < 8; ++i) { y[i] -= mu; vs += y[i] * y[i]; }
            vs += __shfl_xor(vs, 1); vs += __shfl_xor(vs, 2); vs += __shfl_xor(vs, 4);
            const float rs = 1.0f / sqrtf(vs * (1.0f / 64.0f) + 64e-5f);
            const bf16* pv = P + (size_t)m * PLD_AB + 768 + 1024 + c0;
            const bf16x8 vc = *(const bf16x8*)pv; bf16x8 vp = vc, vn = vc;
            const bool hp = t > 0, hn = t < T - 1;
            if (hp) vp = *(const bf16x8*)(pv - PLD_AB); if (hn) vn = *(const bf16x8*)(pv + PLD_AB);
            const float bon = BC[(size_t)m * 8 + head] + BC[((size_t)MTOK + m) * 8 + head];
            float o[8];
#pragma unroll
            for (int i = 0; i < 8; ++i) { const float c = bf2f((unsigned short)vc[i]); const float pvv = hp ? bf2f((unsigned short)vp[i]) : 0.f, nvv = hn ? bf2f((unsigned short)vn[i]) : 0.f;
                const float v = c + mpv[i] * (pvv - c) + mnv[i] * (nvv - c);
                o[i] = (y[i] * rs * gnw[i] + gnb[i] + bon * v) * acc[tt][i]; }
            *(u32x4*)(O + (size_t)m * 1024 + 512 + c0) = (u32x4){pk2(o[0], o[1]), pk2(o[2], o[3]), pk2(o[4], o[5]), pk2(o[6], o[7])};
        }
        asm volatile("s_waitcnt lgkmcnt(0)" ::: "memory");
    }
}
constexpr int PT = 72;
constexpr int SLOT = 64 * PT * 2;
constexpr int F32P = 68;
__device__ __forceinline__ LAS bf16* slot(Frame& F, int k) { return (LAS bf16*)(F.lds + k * SLOT); }
__device__ __forceinline__ void mm64(f32x16 (&acc)[2][2], const LAS bf16* A, const LAS bf16* B, int lane) {
    const int r = lane & 31, h = lane >> 5;
#pragma unroll
    for (int ks = 0; ks < 4; ++ks) {
        bf16x8 af[2], bfr[2];
#pragma unroll
        for (int t = 0; t < 2; ++t) { af[t] = *(const LAS bf16x8*)(A + (32 * t + r) * PT + 16 * ks + 8 * h); bfr[t] = *(const LAS bf16x8*)(B + (32 * t + r) * PT + 16 * ks + 8 * h); }
#pragma unroll
        for (int rt = 0; rt < 2; ++rt)
#pragma unroll
            for (int ct = 0; ct < 2; ++ct) acc[rt][ct] = MFMA32(af[rt], bfr[ct], acc[rt][ct]);
    }
}
__device__ __forceinline__ void mm64_gB(f32x16 (&acc)[2][2], const LAS bf16* A, const bf16* Bg, int lane) {
    const int r = lane & 31, h = lane >> 5;
#pragma unroll
    for (int ks = 0; ks < 4; ++ks) {
        bf16x8 af[2], bfr[2];
#pragma unroll
        for (int t = 0; t < 2; ++t) { af[t] = *(const LAS bf16x8*)(A + (32 * t + r) * PT + 16 * ks + 8 * h); bfr[t] = *(const bf16x8*)(Bg + (32 * t + r) * 64 + 16 * ks + 8 * h); }
#pragma unroll
        for (int rt = 0; rt < 2; ++rt)
#pragma unroll
            for (int ct = 0; ct < 2; ++ct) acc[rt][ct] = MFMA32(af[rt], bfr[ct], acc[rt][ct]);
    }
}
__device__ __forceinline__ void zero_acc(f32x16 (&acc)[2][2]) {
#pragma unroll
    for (int a = 0; a < 2; ++a)
#pragma unroll
        for (int b = 0; b < 2; ++b)
#pragma unroll
            for (int i = 0; i < 16; ++i) acc[a][b][i] = 0.f;
}
template <int MASK> __device__ __forceinline__ void store_nat_bf16(const f32x16 (&acc)[2][2], LAS bf16* D, int lane) {
    const int r = lane & 31, h = lane >> 5;
#pragma unroll
    for (int rt = 0; rt < 2; ++rt)
#pragma unroll
        for (int ct = 0; ct < 2; ++ct)
#pragma unroll
            for (int i = 0; i < 16; i += 2) { const int row = 32 * rt + crow(i, h), col = 32 * ct + r; float v0 = acc[rt][ct][i], v1 = acc[rt][ct][i + 1];
                if (MASK && rt < ct) { v0 = 0.f; v1 = 0.f; }
                if (MASK == 1 && rt == ct) { v0 *= (float)((unsigned)(col - row) >> 31); v1 *= (float)((unsigned)(col - row - 1) >> 31); }
                if (MASK == 2 && rt == ct) { v0 *= (float)((unsigned)(col - row - 1) >> 31); v1 *= (float)((unsigned)(col - row - 2) >> 31); }
                const unsigned w = pk2(v0, v1);
                D[row * PT + col] = (bf16)(w & 0xffffu); D[(row + 1) * PT + col] = (bf16)(w >> 16); }
}
template <int MASK> __device__ __forceinline__ void store_nat_f32(const f32x16 (&acc)[2][2], LAS float* D, int lane) {
    const int r = lane & 31, h = lane >> 5;
#pragma unroll
    for (int rt = 0; rt < 2; ++rt)
#pragma unroll
        for (int ct = 0; ct < 2; ++ct)
#pragma unroll
            for (int i = 0; i < 16; ++i) { const int row = 32 * rt + crow(i, h), col = 32 * ct + r; float v = acc[rt][ct][i];
                if (MASK == 1 && rt < ct) v = 0.f;
                if (MASK == 1 && rt == ct) v *= (float)((unsigned)(col - row) >> 31);
                D[row * F32P + col] = v; }
}
__device__ __forceinline__ void store_tr_g(const f32x16 (&acc)[2][2], bf16* D, long pitch, int lane) {
    const int r = lane & 31, h = lane >> 5;
#pragma unroll
    for (int rt = 0; rt < 2; ++rt)
#pragma unroll
        for (int ct = 0; ct < 2; ++ct)
#pragma unroll
            for (int g = 0; g < 4; ++g) { const int row = 32 * rt + 8 * g + 4 * h, col = 32 * ct + r;
                *(u32x2*)(D + (long)col * pitch + row) = (u32x2){pk2(acc[rt][ct][4 * g], acc[rt][ct][4 * g + 1]), pk2(acc[rt][ct][4 * g + 2], acc[rt][ct][4 * g + 3])}; }
}
__device__ __forceinline__ void load8(float (&o)[8], const bf16* p) { const bf16x8 v = *(const bf16x8*)p;
#pragma unroll
    for (int i = 0; i < 8; ++i) o[i] = bf2f((unsigned short)v[i]); }
__device__ __forceinline__ void shift8(float (&o)[8], const bf16* p, bool hp, bool hn, const float* mup, const float* mun) {
    float c[8], a[8], b[8]; load8(c, p);
    if (hp) load8(a, p - PLD_AB); if (hn) load8(b, p + PLD_AB);
#pragma unroll
    for (int i = 0; i < 8; ++i) { const float pv = hp ? a[i] : 0.f, nx = hn ? b[i] : 0.f; o[i] = c[i] + mup[i] * (pv - c[i]) + mun[i] * (nx - c[i]); }
}
__device__ __forceinline__ void solve_col(const LAS float* A, const LAS bf16* rhs, LAS bf16* dst, int lane) {
    float x[64];
    { int z = 0; asm volatile("" : "+v"(z)); A += z; }
#pragma unroll
    for (int t = 0; t < 64; ++t) x[t] = bf2f(rhs[t * PT + lane]);
    asm volatile("s_waitcnt lgkmcnt(0)" ::: "memory");
    x[1] -= A[1 * F32P + 0] * x[0];
#pragma unroll
    for (int t = 2; t < 64; t += 2) {
        float s0 = 0.f, s1 = 0.f, r0 = 0.f, r1 = 0.f;
#pragma unroll
        for (int u4 = 0; u4 < t / 4 + 1; ++u4) { if (4 * u4 < t) { const f32x4 a = *(const LAS f32x4*)(A + t * F32P + 4 * u4), b = *(const LAS f32x4*)(A + (t + 1) * F32P + 4 * u4);
            if (4 * u4 + 0 < t) { s0 += a[0] * x[4 * u4 + 0]; r0 += b[0] * x[4 * u4 + 0]; } if (4 * u4 + 1 < t) { s1 += a[1] * x[4 * u4 + 1]; r1 += b[1] * x[4 * u4 + 1]; }
            if (4 * u4 + 2 < t) { s0 += a[2] * x[4 * u4 + 2]; r0 += b[2] * x[4 * u4 + 2]; } if (4 * u4 + 3 < t) { s1 += a[3] * x[4 * u4 + 3]; r1 += b[3] * x[4 * u4 + 3]; } } }
        x[t] -= s0 + s1;
        x[t + 1] -= (r0 + r1) + A[(t + 1) * F32P + t] * x[t];
        asm volatile("" : "+v"(x[t]), "+v"(x[t + 1]));
    }
    asm volatile("s_waitcnt lgkmcnt(0)" ::: "memory");
#pragma unroll
    for (int q = 0; q < 8; ++q)
        *(LAS u32x4*)(dst + lane * PT + 8 * q) = (u32x4){pk2(x[8 * q], x[8 * q + 1]), pk2(x[8 * q + 2], x[8 * q + 3]), pk2(x[8 * q + 4], x[8 * q + 5]), pk2(x[8 * q + 6], x[8 * q + 7])};
    asm volatile("s_waitcnt lgkmcnt(0)" ::: "memory");
}
constexpr size_t WS_LORA = 7 * MiB;
constexpr size_t WS_R = WS_END;
constexpr size_t WS_END2 = WS_R + 80 * MiB;
__device__ __forceinline__ int r_item(bool latent, int b, int h, int c) { return latent ? ((b * 8 + h) * 64 + c) : (4096 + (b * 8 + h) * 4 + c); }

__device__ __forceinline__ void shift8c(float (&o)[8], const bf16x8& rc, const bf16* p, bool hp, bool hn, const float* mup, const float* mun) {
    float a[8], b[8];
    if (hp) load8(a, p - PLD_AB); if (hn) load8(b, p + PLD_AB);
#pragma unroll
    for (int i = 0; i < 8; ++i) { const float c = bf2f((unsigned short)rc[i]); const float pv = hp ? a[i] : 0.f, nx = hn ? b[i] : 0.f; o[i] = c + mup[i] * (pv - c) + mun[i] * (nx - c); }
}
__device__ __forceinline__ void bar_all() { asm volatile("s_waitcnt vmcnt(0) lgkmcnt(0)" ::: "memory"); __builtin_amdgcn_s_barrier(); asm volatile("" ::: "memory"); }
__device__ __forceinline__ void rwkv_r1(Frame& F, int jl, int d) {
    LAS bf16* S0 = slot(F, 0); LAS bf16* S1 = slot(F, 1); LAS bf16* S2 = slot(F, 2); LAS bf16* S3 = slot(F, 3); LAS bf16* S4 = slot(F, 4);
    LAS bf16* S5 = slot(F, 5); LAS bf16* S6 = slot(F, 6); LAS bf16* S7 = slot(F, 7); LAS bf16* S8 = slot(F, 8);
    LAS bf16* S9 = slot(F, 9); LAS bf16* S10 = slot(F, 10); LAS bf16* S11 = slot(F, 11);
    LAS float* F32 = (LAS float*)(F.lds + 12 * SLOT); LAS float* PCv = F32 + 64 * F32P; LAS float* KN = PCv + 64; LAS float* BN = KN + 512;
    const bf16* P = (const bf16*)(F.ws + WS_G);
    bf16* Yd = (bf16*)(F.ws + WS_Y) + (size_t)d * MTOK * 512; bf16* Ob = (bf16*)(F.ws + WS_H);
    float* BC = (float*)(F.ws + WS_BC) + (size_t)d * MTOK * 8;
    const float* mup_u = F.in[I_MUP] + jl * 1920; const float* mun_u = F.in[I_MUN] + jl * 1920;
    const int w = F.wave;
    bf16x8 rawc[5];
#define R1_LOADRAW(IT, LANE) do { int b_, h_, c_, T_, m0_; if ((IT) < 4096) { b_ = (IT) >> 9; h_ = ((IT) >> 6) & 7; c_ = (IT) & 63; T_ = TL; m0_ = MPR + b_ * TL; } \
        else { const int p_ = (IT) - 4096; b_ = p_ >> 5; h_ = (p_ >> 2) & 7; c_ = p_ & 3; T_ = TP; m0_ = b_ * TP; } \
        const int tok_ = d ? T_ - 1 - (64 * c_ + (LANE)) : 64 * c_ + (LANE); const bf16* pr_ = P + (size_t)(m0_ + tok_) * PLD_AB + 768 + 8 * w; const int hc_ = h_ * 64; \
        rawc[0] = *(const bf16x8*)(pr_ + hc_); rawc[1] = *(const bf16x8*)(pr_ + 1024 + hc_); rawc[2] = *(const bf16x8*)(pr_ + 1536 + d * 64); rawc[3] = *(const bf16x8*)(pr_ + 1664 + d * 64); rawc[4] = *(const bf16x8*)(pr_ + 512 + hc_); } while (0)
    if (F.bid < 5120) R1_LOADRAW(F.bid, F.lane);
    for (int it = F.bid; it < 5120; it += F.G) {
        int lane = F.lane; asm volatile("" : "+v"(lane));
        int zv = 0; asm volatile("" : "+v"(zv));
        const float* mup = mup_u + zv; const float* mun = mun_u + zv;
        const float* pKK = F.in[I_BKK] + jl * 512 + zv; const float* pKA = F.in[I_BKA] + jl * 512 + zv; const float* pRK = F.in[I_BRK] + jl * 512 + zv; const float* pA0 = F.in[I_BA0] + (jl * 2 + d) * 512 + zv;
        int b, h, c, T, m0; const bool latent = it < 4096;
        if (latent) { b = it >> 9; h = (it >> 6) & 7; c = it & 63; T = TL; m0 = MPR + b * TL; }
        else { const int p = it - 4096; b = p >> 5; h = (p >> 2) & 7; c = p & 3; T = TP; m0 = b * TP; }
        const int tok = d ? T - 1 - (64 * c + lane) : 64 * c + lane;
        const bool hp = tok > 0, hn = tok < T - 1;
        const bf16* prow = P + (size_t)(m0 + tok) * PLD_AB + 768;
        const int hc = h * 64, q = w;
        const int r = lane & 31, hh = lane >> 5;
        float k8[8], r8[8], v8[8];
        shift8c(r8, rawc[0], prow + hc + 8 * q, hp, hn, mup + hc + 8 * q, mun + hc + 8 * q);
        shift8c(v8, rawc[1], prow + 1024 + hc + 8 * q, hp, hn, mup + 1024 + hc + 8 * q, mun + 1024 + hc + 8 * q);
        { float x[8];
          shift8c(x, rawc[2], prow + 1536 + d * 64 + 8 * q, hp, hn, mup + 1536 + d * 64 + 8 * q, mun + 1536 + d * 64 + 8 * q);
          *(LAS u32x4*)(S0 + lane * PT + 8 * q) = (u32x4){pk2(tanh_f(x[0]), tanh_f(x[1])), pk2(tanh_f(x[2]), tanh_f(x[3])), pk2(tanh_f(x[4]), tanh_f(x[5])), pk2(tanh_f(x[6]), tanh_f(x[7]))};
          shift8c(x, rawc[3], prow + 1664 + d * 64 + 8 * q, hp, hn, mup + 1664 + d * 64 + 8 * q, mun + 1664 + d * 64 + 8 * q);
          *(LAS u32x4*)(S1 + lane * PT + 8 * q) = (u32x4){pk2(x[0], x[1]), pk2(x[2], x[3]), pk2(x[4], x[5]), pk2(x[6], x[7])};
          shift8c(k8, rawc[4], prow + 512 + hc + 8 * q, hp, hn, mup + 512 + hc + 8 * q, mun + 512 + hc + 8 * q);
          float ss = 0.f;
#pragma unroll
          for (int i = 0; i < 8; ++i) { const float kv = k8[i] * pKK[hc + 8 * q + i]; ss += kv * kv; }
          KN[q * 64 + lane] = ss; }
        bar_all();
        if (w == 0) { f32x16 acc[2][2]; zero_acc(acc); mm64_gB(acc, S0, (const bf16*)(F.ws + WS_LORA) + ((size_t)(jl * 2 + d) * 512 + hc) * 64, lane); store_nat_f32<0>(acc, F32, lane); }
        else if (w == 1) { f32x16 acc[2][2]; zero_acc(acc); mm64_gB(acc, S1, (const bf16*)(F.ws + WS_LORA) + ((size_t)(4 + jl * 2 + d) * 512 + hc) * 64, lane); store_nat_bf16<0>(acc, S2, lane); }
        bar_all();
        { const float w0 = F.in[I_BW0][(jl * 2 + d) * 512 + hc + lane];
#pragma unroll
          for (int tt = 0; tt < 8; ++tt) { const int t = 8 * w + tt; const float x = -(w0 + F32[t * F32P + lane]); const float sp = fmaxf(x, 0.f) + 0.6931471805599453f * __builtin_amdgcn_logf(1.0f + __builtin_amdgcn_exp2f(-1.4426950408889634f * fabsf(x)));
              F32[t * F32P + lane] = -__expf(-sp - 0.5f); } }
        bar_all();
        if (w == 0) { float cum = 0.f;
#pragma unroll 16
          for (int t = 0; t < 64; ++t) { cum += F32[t * F32P + lane]; F32[t * F32P + lane] = cum; }
          PCv[lane] = cum; }
        bar_all();
        { float ss = 0.f;
#pragma unroll
          for (int u = 0; u < 8; ++u) ss += KN[u * 64 + lane];
          const float knorm = 1.0f / fmaxf(sqrtf(ss), 1e-12f);
          float al[8], lp[8], lpm[8];
          { const bf16x8 av = *(const LAS bf16x8*)(S2 + lane * PT + 8 * q);
#pragma unroll
            for (int i = 0; i < 8; ++i) al[i] = bf2f((unsigned short)av[i]); }
          { const f32x4 a = *(const LAS f32x4*)(F32 + lane * F32P + 8 * q), b4 = *(const LAS f32x4*)(F32 + lane * F32P + 8 * q + 4);
            lp[0] = a[0]; lp[1] = a[1]; lp[2] = a[2]; lp[3] = a[3]; lp[4] = b4[0]; lp[5] = b4[1]; lp[6] = b4[2]; lp[7] = b4[3];
            if (lane > 0) { const f32x4 c4 = *(const LAS f32x4*)(F32 + (lane - 1) * F32P + 8 * q), d4 = *(const LAS f32x4*)(F32 + (lane - 1) * F32P + 8 * q + 4);
                lpm[0] = c4[0]; lpm[1] = c4[1]; lpm[2] = c4[2]; lpm[3] = c4[3]; lpm[4] = d4[0]; lpm[5] = d4[1]; lpm[6] = d4[2]; lpm[7] = d4[3]; }
            else {
#pragma unroll
                for (int i = 0; i < 8; ++i) lpm[i] = 0.f; } }
          float kkh[8], bt[8], kt[8], rh[8]; float bonus = 0.f;
#pragma unroll
          for (int i = 0; i < 8; ++i) { const int j = hc + 8 * q + i;
              const float a = sigmoid_f(pA0[j] + al[i]);
              const float kk = k8[i] * pKK[j] * knorm;
              const float kd = k8[i] * (1.0f + (a - 1.0f) * pKA[j]);
              const float bb = kk * a;
              bonus += r8[i] * kd * pRK[j];
              const float ip = __expf(-lp[i]), pcp = __expf(PCv[8 * q + i] - lp[i]);
              kkh[i] = kk * __expf(lpm[i]); bt[i] = bb * ip; kt[i] = kd * ip; rh[i] = r8[i] * __expf(lp[i]);
              S5[(8 * q + i) * PT + lane] = (bf16)f2bf(bb * pcp); S6[(8 * q + i) * PT + lane] = (bf16)f2bf(kd * pcp); S7[(8 * q + i) * PT + lane] = (bf16)f2bf(v8[i]); }
          *(LAS u32x4*)(S0 + lane * PT + 8 * q) = (u32x4){pk2(kkh[0], kkh[1]), pk2(kkh[2], kkh[3]), pk2(kkh[4], kkh[5]), pk2(kkh[6], kkh[7])};
          *(LAS u32x4*)(S1 + lane * PT + 8 * q) = (u32x4){pk2(bt[0], bt[1]), pk2(bt[2], bt[3]), pk2(bt[4], bt[5]), pk2(bt[6], bt[7])};
          *(LAS u32x4*)(S3 + lane * PT + 8 * q) = (u32x4){pk2(kt[0], kt[1]), pk2(kt[2], kt[3]), pk2(kt[4], kt[5]), pk2(kt[6], kt[7])};
          *(LAS u32x4*)(S4 + lane * PT + 8 * q) = (u32x4){pk2(rh[0], rh[1]), pk2(rh[2], rh[3]), pk2(rh[4], rh[5]), pk2(rh[6], rh[7])};
          BN[q * 64 + lane] = bonus; }
        bar_all();
        if (w == 0) { f32x16 acc[2][2]; zero_acc(acc); mm64(acc, S0, S1, lane); store_nat_f32<1>(acc, F32, lane); }
        else if (w == 1) { f32x16 acc[2][2]; zero_acc(acc); mm64(acc, S0, S3, lane); store_nat_bf16<1>(acc, S2, lane);
            asm volatile("s_waitcnt lgkmcnt(0)" ::: "memory");
            zero_acc(acc); mm64(acc, S2, S7, lane); store_nat_bf16<0>(acc, S8, lane); }
        else if (w == 2) { f32x16 acc[2][2]; zero_acc(acc); mm64(acc, S4, S1, lane); store_nat_bf16<2>(acc, S9, lane); }
        else if (w == 3) { f32x16 acc[2][2]; zero_acc(acc); mm64(acc, S4, S3, lane); store_nat_bf16<2>(acc, S10, lane); }
        else if (w == 4) { float bs = 0.f;
#pragma unroll
            for (int u = 0; u < 8; ++u) bs += BN[u * 64 + lane];
            BC[(size_t)(m0 + tok) * 8 + h] = bs; }
        bar_all();
        if (w == 0) solve_col(F32, S0, S0, lane);
        else if (w == 1) solve_col(F32, S8, S11, lane);
        bar_all();
        if (it + F.G < 5120) R1_LOADRAW(it + F.G, lane);
        bf16* RM = (bf16*)(F.ws + WS_R) + (size_t)it * 8192;
        if (w == 0) { f32x16 acc[2][2]; zero_acc(acc); mm64(acc, S0, S5, lane);
          float pcc[2]; pcc[0] = __expf(PCv[r]); pcc[1] = __expf(PCv[32 + r]);
#pragma unroll
          for (int rt = 0; rt < 2; ++rt)
#pragma unroll
              for (int ct = 0; ct < 2; ++ct)
#pragma unroll
                  for (int i = 0; i < 16; ++i) { const int row = 32 * rt + crow(i, hh), col = 32 * ct + r; acc[rt][ct][i] = (row == col ? pcc[ct] : 0.f) - acc[rt][ct][i]; }
#pragma unroll
          for (int jq = 0; jq < 2; ++jq)
#pragma unroll
              for (int jt = 0; jt < 2; ++jt)
#pragma unroll
                  for (int s2 = 0; s2 < 2; ++s2) *(bf16x8*)(RM + ((jq * 2 + jt) * 2 + s2) * 512 + lane * 8) = pack8(acc[jt][jq], s2); }
        else if (w == 1) { f32x16 a1[2][2]; zero_acc(a1); mm64(a1, S5, S11, lane);
#pragma unroll
          for (int rt = 0; rt < 2; ++rt)
#pragma unroll
              for (int ct = 0; ct < 2; ++ct) a1[rt][ct] = -a1[rt][ct];
          mm64(a1, S6, S7, lane);
#pragma unroll
          for (int jq = 0; jq < 2; ++jq)
#pragma unroll
              for (int it2 = 0; it2 < 2; ++it2)
#pragma unroll
                  for (int s2 = 0; s2 < 2; ++s2) *(bf16x8*)(RM + 4096 + ((jq * 2 + it2) * 2 + s2) * 512 + lane * 8) = pack8(a1[jq][it2], s2); }
        else if (w == 2) { f32x16 a1[2][2]; zero_acc(a1); mm64(a1, S0, S9, lane);
#pragma unroll
          for (int jt = 0; jt < 2; ++jt)
#pragma unroll
              for (int ct = 0; ct < 2; ++ct) { const int t = 32 * ct + r; const int tk = d ? T - 1 - (64 * c + t) : 64 * c + t;
#pragma unroll
                  for (int s2 = 0; s2 < 2; ++s2) { const int j0 = 32 * jt + 16 * s2 + 4 * hh;
                      const s16x4 ra = *(const LAS s16x4*)(S4 + t * PT + j0), rb = *(const LAS s16x4*)(S4 + t * PT + j0 + 8);
                      u32x4 wv; wv.x = pk2(bf2f((unsigned short)ra[0]) - a1[jt][ct][8 * s2], bf2f((unsigned short)ra[1]) - a1[jt][ct][8 * s2 + 1]); wv.y = pk2(bf2f((unsigned short)ra[2]) - a1[jt][ct][8 * s2 + 2], bf2f((unsigned short)ra[3]) - a1[jt][ct][8 * s2 + 3]);
                      wv.z = pk2(bf2f((unsigned short)rb[0]) - a1[jt][ct][8 * s2 + 4], bf2f((unsigned short)rb[1]) - a1[jt][ct][8 * s2 + 5]); wv.w = pk2(bf2f((unsigned short)rb[2]) - a1[jt][ct][8 * s2 + 6], bf2f((unsigned short)rb[3]) - a1[jt][ct][8 * s2 + 7]);
                      *(u32x4*)(Ob + (size_t)(m0 + tk) * 1024 + 512 + hc + ((jt * 2 + s2) * 2 + hh) * 8) = wv; } } }
        else if (w == 3) { f32x16 a1[2][2]; zero_acc(a1); mm64(a1, S11, S9, lane);
#pragma unroll
          for (int rt = 0; rt < 2; ++rt)
#pragma unroll
              for (int ct = 0; ct < 2; ++ct) a1[rt][ct] = -a1[rt][ct];
          mm64(a1, S7, S10, lane);
#pragma unroll
          for (int rt = 0; rt < 2; ++rt)
#pragma unroll
              for (int ct = 0; ct < 2; ++ct)
#pragma unroll
                  for (int g = 0; g < 4; ++g) { const int i0 = 32 * rt + 8 * g + 4 * hh, t = 32 * ct + r; const int tk = d ? T - 1 - (64 * c + t) : 64 * c + t;
                      *(u32x2*)(Yd + (size_t)(m0 + tk) * 512 + hc + i0) = (u32x2){pk2(a1[rt][ct][4 * g], a1[rt][ct][4 * g + 1]), pk2(a1[rt][ct][4 * g + 2], a1[rt][ct][4 * g + 3])}; } }
        bar_all();
    }
#undef R1_LOADRAW
}

__device__ __forceinline__ bf16x8 ld_perm(const bf16* p) {
    const s16x4 lo = *(const s16x4*)p, hi = *(const s16x4*)(p + 8); return __builtin_shufflevector(lo, hi, 0, 1, 2, 3, 4, 5, 6, 7);
}
__device__ __forceinline__ void rwkv_r2a(Frame& F, int jl, int d) {
    const int sc = F.wave * F.G + F.bid;
    if (F.wave >= 2 || sc >= 320) return;
    const int lane = F.lane, r = lane & 31, hh = lane >> 5;
    int b, h, T; const bool latent = sc < 64;
    if (latent) { b = sc >> 3; h = sc & 7; T = TL; } else { const int p = sc - 64; b = p >> 3; h = p & 7; T = TP; }
    f32x16 S[2][2];
    if (latent) { const float* sp = F.in[I_SB] + (size_t)(((b * 2 + jl) * 2 + d) * 8 + h) * 4096;
#pragma unroll
        for (int jt = 0; jt < 2; ++jt)
#pragma unroll
            for (int it = 0; it < 2; ++it)
#pragma unroll
                for (int g = 0; g < 4; ++g) { const f32x4 v = *(const f32x4*)(sp + (32 * it + r) * 64 + 32 * jt + 8 * g + 4 * hh);
                    S[jt][it][4 * g] = v[0]; S[jt][it][4 * g + 1] = v[1]; S[jt][it][4 * g + 2] = v[2]; S[jt][it][4 * g + 3] = v[3]; } }
    else zero_acc(S);
    const int NC = T / 64;
    LAS unsigned char* ring = F.lds + F.wave * 65536;
    constexpr int DEPTH = 3;
#define R2_DMA(CI) do { const bf16* RM_ = (const bf16*)(F.ws + WS_R) + (size_t)r_item(latent, b, h, (CI)) * 8192 + lane * 8; \
        LAS unsigned char* dst_ = ring + ((CI) & 3) * 16384; \
        _Pragma("unroll") for (int f_ = 0; f_ < 16; ++f_) __builtin_amdgcn_global_load_lds((const unsigned*)(RM_ + f_ * 512), (LAS unsigned*)(dst_ + f_ * 1024), 16, 0, 0); } while (0)
    for (int c0 = 0; c0 < DEPTH && c0 < NC; ++c0) R2_DMA(c0);
    for (int c = 0; c < NC; ++c) {
        bf16* RMc = (bf16*)(F.ws + WS_R) + (size_t)r_item(latent, b, h, c) * 8192 + lane * 8;
        const int rem = NC - 1 - c;
        const int allow = 16 * (rem < 2 ? rem : 2) + 8 * (c < 2 ? c : 2);
        if (allow >= 48) asm volatile("s_waitcnt vmcnt(48)" ::: "memory"); else if (allow >= 40) asm volatile("s_waitcnt vmcnt(40)" ::: "memory");
        else if (allow >= 32) asm volatile("s_waitcnt vmcnt(32)" ::: "memory"); else if (allow >= 24) asm volatile("s_waitcnt vmcnt(24)" ::: "memory");
        else if (allow >= 16) asm volatile("s_waitcnt vmcnt(16)" ::: "memory"); else if (allow >= 8) asm volatile("s_waitcnt vmcnt(8)" ::: "memory");
        else asm volatile("s_waitcnt vmcnt(0)" ::: "memory");
        const LAS bf16x8* fr = (const LAS bf16x8*)(ring + (c & 3) * 16384) + lane;
        bf16x8 Mc[2][2][2], Nc[2][2][2];
#pragma unroll
        for (int a_ = 0; a_ < 2; ++a_)
#pragma unroll
            for (int b_ = 0; b_ < 2; ++b_)
#pragma unroll
                for (int s2 = 0; s2 < 2; ++s2) { Mc[a_][b_][s2] = fr[((a_ * 2 + b_) * 2 + s2) * 64]; Nc[a_][b_][s2] = fr[(8 + (a_ * 2 + b_) * 2 + s2) * 64]; }
        asm volatile("s_waitcnt lgkmcnt(0)" ::: "memory");
        bf16x8 Sb[2][2][2];
#pragma unroll
        for (int jt = 0; jt < 2; ++jt)
#pragma unroll
            for (int s2 = 0; s2 < 2; ++s2)
#pragma unroll
                for (int it = 0; it < 2; ++it) { Sb[jt][s2][it] = pack8(S[jt][it], s2); *(bf16x8*)(RMc + ((jt * 2 + s2) * 2 + it) * 512) = Sb[jt][s2][it]; }
        if (c + DEPTH < NC) R2_DMA(c + DEPTH);
        f32x16 Sn[2][2];
#pragma unroll
        for (int jq = 0; jq < 2; ++jq)
#pragma unroll
            for (int it = 0; it < 2; ++it)
#pragma unroll
                for (int s2 = 0; s2 < 2; ++s2)
#pragma unroll
                    for (int jj = 0; jj < 8; ++jj) Sn[jq][it][8 * s2 + jj] = bf2f((unsigned short)Nc[jq][it][s2][jj]);
#pragma unroll
        for (int jq = 0; jq < 2; ++jq)
#pragma unroll
            for (int jt = 0; jt < 2; ++jt)
#pragma unroll
                for (int s2 = 0; s2 < 2; ++s2)
#pragma unroll
                    for (int it = 0; it < 2; ++it) Sn[jq][it] = MFMA32(Mc[jq][jt][s2], Sb[jt][s2][it], Sn[jq][it]);
#pragma unroll
        for (int jq = 0; jq < 2; ++jq)
#pragma unroll
            for (int it = 0; it < 2; ++it) S[jq][it] = Sn[jq][it];
    }
    asm volatile("s_waitcnt vmcnt(0)" ::: "memory");
#define R2_LOAD(x)
#undef R2_LOAD
    if (!latent) { float* op = F.out + O_BW + (size_t)(((b * 2 + jl) * 2 + d) * 8 + h) * 4096;
#pragma unroll
        for (int jt = 0; jt < 2; ++jt)
#pragma unroll
            for (int it = 0; it < 2; ++it)
#pragma unroll
                for (int g = 0; g < 4; ++g) *(f32x4*)(op + (32 * it + r) * 64 + 32 * jt + 8 * g + 4 * hh) = (f32x4){S[jt][it][4 * g], S[jt][it][4 * g + 1], S[jt][it][4 * g + 2], S[jt][it][4 * g + 3]}; }
}
__device__ __forceinline__ void rwkv_r2b(Frame& F, int jl, int d) {
    const int lane = F.lane, r = lane & 31, hh = lane >> 5;
    bf16* Yd = (bf16*)(F.ws + WS_Y) + (size_t)d * MTOK * 512; const bf16* Ob = (const bf16*)(F.ws + WS_H);
    for (int it = F.bid * 8 + F.wave; it < 5120; it += F.G * 8) {
        int b, h, c, T, m0; const bool latent = it < 4096;
        if (latent) { b = it >> 9; h = (it >> 6) & 7; c = it & 63; T = TL; m0 = MPR + b * TL; }
        else { const int p = it - 4096; b = p >> 5; h = (p >> 2) & 7; c = p & 3; T = TP; m0 = b * TP; }
        const int hc = h * 64;
        const bf16* RM = (const bf16*)(F.ws + WS_R) + (size_t)it * 8192 + lane * 8;
        bf16x8 Sb[2][2][2];
#pragma unroll
        for (int jt = 0; jt < 2; ++jt)
#pragma unroll
            for (int s2 = 0; s2 < 2; ++s2)
#pragma unroll
                for (int i2 = 0; i2 < 2; ++i2) Sb[jt][s2][i2] = *(const bf16x8*)(RM + ((jt * 2 + s2) * 2 + i2) * 512);
#pragma unroll
        for (int tt = 0; tt < 2; ++tt) {
            const int t = 32 * tt + r; const int tk = d ? T - 1 - (64 * c + t) : 64 * c + t;
            const bf16* qp = Ob + (size_t)(m0 + tk) * 1024 + 512 + hc + 8 * hh; bf16* yp = Yd + (size_t)(m0 + tk) * 512 + hc + 4 * hh;
            f32x16 y[2];
#pragma unroll
            for (int i2 = 0; i2 < 2; ++i2)
#pragma unroll
                for (int g = 0; g < 4; ++g) { const s16x4 z = *(const s16x4*)(yp + 32 * i2 + 8 * g);
                    y[i2][4 * g] = bf2f((unsigned short)z[0]); y[i2][4 * g + 1] = bf2f((unsigned short)z[1]); y[i2][4 * g + 2] = bf2f((unsigned short)z[2]); y[i2][4 * g + 3] = bf2f((unsigned short)z[3]); }
#pragma unroll
            for (int jt = 0; jt < 2; ++jt)
#pragma unroll
                for (int s2 = 0; s2 < 2; ++s2) { const bf16x8 qf = *(const bf16x8*)(qp + (jt * 2 + s2) * 16);
#pragma unroll
                    for (int i2 = 0; i2 < 2; ++i2) y[i2] = MFMA32(Sb[jt][s2][i2], qf, y[i2]); }
#pragma unroll
            for (int i2 = 0; i2 < 2; ++i2)
#pragma unroll
                for (int g = 0; g < 4; ++g) *(u32x2*)(yp + 32 * i2 + 8 * g) = (u32x2){pk2(y[i2][4 * g], y[i2][4 * g + 1]), pk2(y[i2][4 * g + 2], y[i2][4 * g + 3])};
        }
    }
}
#ifndef REP_MASK
#define REP_MASK 0
#endif
#ifndef EN_MASK
#define EN_MASK 0xffff
#endif
#define EN(k) (((EN_MASK) >> (k)) & 1)
constexpr int NPHASE = 54;
constexpr int LDS_BYTES = 147456;
constexpr int LDS_BARST = 147200;
#define XB_TMO      128
#define XB_XCNT(j)  (256  + 64 * (j))
#define XB_XSUB(j)  (1280 + 64 * (j))
#define XB_XGEN(j)  (2304 + 64 * (j))
#define XB_TOP      3328
#define XB_TOPGEN   3392
#define XCD_BAR_WORDS 3456
#define XB_SPIN_CAP (1u << 18)

__device__ __forceinline__ unsigned xb_ld(unsigned* p)              { return __hip_atomic_load(p, __ATOMIC_RELAXED, __HIP_MEMORY_SCOPE_AGENT); }
__device__ __forceinline__ unsigned xb_add(unsigned* p, unsigned v) { return __hip_atomic_fetch_add(p, v, __ATOMIC_RELAXED, __HIP_MEMORY_SCOPE_AGENT); }
__device__ __forceinline__ unsigned xb_xcc_id() { return (unsigned)__builtin_amdgcn_s_getreg((3 << 11) | 20) & 0xFu; }
#define XB_SPIN(cond, bar) do { unsigned _sp = 0; while (cond) { __builtin_amdgcn_s_sleep(1); \
    if ((++_sp & 255u) == 0u) { if (xb_ld(&(bar)[XB_TMO])) break; if (_sp > XB_SPIN_CAP) { atomicAdd(&(bar)[XB_TMO], 1u); break; } } } } while (0)

struct XcdBarrier {
    unsigned* bar; unsigned x;
    volatile LAS unsigned* st;
};

__device__ __forceinline__ XcdBarrier xcd_barrier_post(unsigned* bar, volatile LAS unsigned* st) {
    XcdBarrier b; b.bar = bar; b.x = xb_xcc_id(); b.st = st;
    if (threadIdx.x == 0) (void)xb_add(&bar[XB_XCNT(b.x)], 1u);
    return b;
}
__device__ __forceinline__ void xcd_barrier_complete(unsigned* bar, unsigned x, unsigned& nloc, unsigned& nx) {
    const unsigned G = gridDim.x * gridDim.y * gridDim.z;
    unsigned sum, cnt, mine, sp = 0u;
    for (;;) {
        sum = 0u; cnt = 0u; mine = 0u;
#pragma unroll
        for (unsigned j = 0; j < 16; ++j) { const unsigned c = xb_ld(&bar[XB_XCNT(j)]); sum += c; cnt += (c > 0u) ? 1u : 0u; mine = (j == x) ? c : mine; }
        if (sum == G) break;
        __builtin_amdgcn_s_sleep(1);
        if ((++sp & 255u) == 0u) { if (xb_ld(&bar[XB_TMO])) break; if (sp > XB_SPIN_CAP) { atomicAdd(&bar[XB_TMO], 1u); break; } }
    }
    nloc = mine > 0u ? mine : 1u; nx = cnt > 0u ? cnt : 1u;
}

__device__ __forceinline__ void xcd_barrier(const XcdBarrier& b) {
    asm volatile("s_waitcnt vmcnt(0)" ::: "memory");
    __syncthreads();
    if (threadIdx.x == 0) {
        unsigned* bar = b.bar;
        __builtin_amdgcn_s_waitcnt(0);
        unsigned nloc = b.st[0], nx = b.st[1];
        if (nloc == 0u) { xcd_barrier_complete(bar, b.x, nloc, nx); b.st[0] = nloc; b.st[1] = nx; }
        const unsigned old = xb_add(&bar[XB_XSUB(b.x)], 1u);
        const unsigned gen = old / nloc;
        if (old + 1u == (gen + 1u) * nloc) {
            __builtin_amdgcn_fence(__ATOMIC_RELEASE, "agent");
            asm volatile("s_waitcnt vmcnt(0)" ::: "memory");
            const unsigned og = xb_add(&bar[XB_TOP], 1u);
            const unsigned tg = og / nx;
            if (og + 1u == (tg + 1u) * nx) xb_add(&bar[XB_TOPGEN], 1u);
            else XB_SPIN(xb_ld(&bar[XB_TOPGEN]) == tg, bar);
            __builtin_amdgcn_fence(__ATOMIC_ACQUIRE, "agent");
            xb_add(&bar[XB_XGEN(b.x)], 1u);
            asm volatile("s_waitcnt vmcnt(0)" ::: "memory");
        } else {
            XB_SPIN(xb_ld(&bar[XB_XGEN(b.x)]) == gen, bar);
            __builtin_amdgcn_fence(__ATOMIC_ACQUIRE, "agent");
            asm volatile("s_waitcnt vmcnt(0)" ::: "memory");
        }
    }
    __syncthreads();
}

__device__ __forceinline__ unsigned launder_s(unsigned x) { unsigned y; asm volatile("s_mov_b32 %0, %1" : "=s"(y) : "s"(x)); return y; }
__device__ __forceinline__ void* launder_ptr(const void* p) {
    const unsigned lo = launder_s((unsigned)(uintptr_t)p), hi = launder_s((unsigned)((uintptr_t)p >> 32));
    return (void*)(((uintptr_t)hi << 32) | (uintptr_t)lo);
}
__global__ void __launch_bounds__(512, 2) fwd_kernel(Args args) {
    extern __shared__ __attribute__((aligned(16))) unsigned char lds_raw[];
    Frame F;
    F.lds = (LAS unsigned char*)lds_raw;
    F.in = args.in; F.out = args.out; F.ws = args.ws;
    unsigned char* ws = args.ws;
    if (threadIdx.x == 0) { ((volatile LAS unsigned*)(F.lds + LDS_BARST))[0] = 0u; ((volatile LAS unsigned*)(F.lds + LDS_BARST))[1] = 0u; }
    __syncthreads();
    XcdBarrier xbar = xcd_barrier_post((unsigned*)args.ws, (volatile LAS unsigned*)(F.lds + LDS_BARST));
    bool first = true; int nseam = 0;
    for (int vp = 2 * args.ph_lo; vp < 2 * args.ph_hi; ++vp) {
        const int ph = vp >> 1, rep = vp & 1;
        { int t_ = threadIdx.x; asm volatile("" : "+v"(t_)); F.tid = t_; F.lane = t_ & 63; F.wave = __builtin_amdgcn_readfirstlane(t_ >> 6);
          F.bid = (int)launder_s(blockIdx.x); F.G = (int)launder_s(gridDim.x); }
        ws = (unsigned char*)launder_ptr(args.ws); F.ws = ws; F.out = (float*)launder_ptr(args.out); F.in = args.in;
        const float* modp = (const float*)(ws + WS_MOD);
        int kind, l = 0, s = 0;
        if (ph == 0) kind = 0; else if (ph == NPHASE - 1) kind = 11;
        int dsel = 0;
        if (ph != 0 && ph != NPHASE - 1) { int q = ph - 1; if (q < 16) { l = 0; } else if (q < 26) { l = 1; q -= 16; } else if (q < 42) { l = 2; q -= 26; } else { l = 3; q -= 42; }
            if (!(l & 1)) { kind = (int)((0x32176fedfc541321ull >> (4 * q)) & 15ull); s = (int)((0x1120000000001000ull >> (4 * q)) & 15ull); dsel = q >= 8; }
            else { kind = (int)((0x321a981321ull >> (4 * q)) & 15ull); s = (int)((0x1120001000ull >> (4 * q)) & 15ull); } }
        const int jl = l >> 1;
        if (rep && !((REP_MASK >> kind) & 1)) continue;
        const float rscale = rep ? 0.f : 1.f;
        if (!first) { if (nseam == 0) { __threadfence(); cg::this_grid().sync(); } else xcd_barrier(xbar); ++nseam; }
        first = false;
        if (kind == 0) { if (EN(0)) prologue(F); }
        else if (kind == 1) { if (EN(1)) norm_phase(F, l, s); }
        else if (kind == 2) { if (EN(2)) {
            pg8::Gemm g{(const pg8::bf16_t*)(ws + WS_H), (const pg8::bf16_t*)(ws + WS_W13) + (size_t)(l * 2 + s) * 5632 * 1024, MTOK, 5632, 1024, 1024};
            pg8::StaticOrder S; S.init(MTOK, 5632, F.G, F.bid); pg8::EpiSwiGLU E{(pg8::bf16_t*)(ws + WS_G)};
            pg8::gemm_phase<pg8::EpiSwiGLU, pg8::StaticOrder, true, true>(F.lds, g, S, E, F.tid); }
        } else if (kind == 3) { if (EN(3)) {
            pg8::Gemm g{(const pg8::bf16_t*)(ws + WS_G), (const pg8::bf16_t*)(ws + WS_W2) + (size_t)(l * 2 + s) * 1024 * 2816, MTOK, 1024, 2816, 2816};
            pg8::StaticOrder S; S.init(MTOK, 1024, F.G, F.bid); pg8::EpiResid<false> E{F.out, modp + (size_t)l * 9 * 9216 + (s == 0 ? 2 : 8) * 1024, 0.5f * rscale};
            pg8::gemm_phase<pg8::EpiResid<false>, pg8::StaticOrder, true, true>(F.lds, g, S, E, F.tid); }
        } else if (kind == 4) { if (EN(4)) {
            pg8::Gemm g{(const pg8::bf16_t*)(ws + WS_H), (const pg8::bf16_t*)(ws + WS_WAB) + (size_t)jl * 2816 * 1024, MTOK, 2816, 1024, 1024};
            pg8::StaticOrder S; S.init(MTOK, 2816, F.G, F.bid);
            pg8::EpiProj<0> E{(pg8::bf16_t*)(ws + WS_G), (pg8::bf16_t*)(ws + WS_G + G_VTA), (const float*)(ws + WS_ROPE), (const float*)(ws + WS_ROPE) + 1024, F.out + O_AK, F.out + O_AV, jl};
            pg8::gemm_phase<pg8::EpiProj<0>, pg8::StaticOrder, true, true>(F.lds, g, S, E, F.tid); }
        } else if (kind == 5) {
            if (EN(5)) rwkv_r1(F, jl, 0);
        } else if (kind == 6) { if (EN(6)) rwkv_post_phase(F, jl); }
        else if (kind == 12 || kind == 14) { if (F.wave < 2) { if (EN(13)) rwkv_r2a(F, jl, kind == 14 ? 1 : 0); } if (EN(12) && !rep) attnA_phase(F, jl); }
        else if (kind == 13) { if (EN(5)) rwkv_r1(F, jl, 1); }
        else if (kind == 15) { if (EN(13)) rwkv_r2b(F, jl, dsel); if (EN(12) && !rep) attnA_phase(F, jl); }
        else if (kind == 7 || kind == 10) { if (EN(7)) {
            pg8::Gemm g{(const pg8::bf16_t*)(ws + WS_H), (const pg8::bf16_t*)(ws + (kind == 7 ? WS_WABO : WS_WCO)) + (size_t)jl * 1024 * 1024, MTOK, 1024, 1024, 1024};
            pg8::StaticOrder S; S.init(MTOK, 1024, F.G, F.bid); pg8::EpiResid<false> E{F.out, modp + (size_t)l * 9 * 9216 + 5 * 1024, rscale};
            pg8::gemm_phase<pg8::EpiResid<false>, pg8::StaticOrder, true, true>(F.lds, g, S, E, F.tid); }
        } else if (kind == 8) { if (EN(8)) {
            pg8::Gemm g{(const pg8::bf16_t*)(ws + WS_H), (const pg8::bf16_t*)(ws + WS_WC) + (size_t)jl * 3072 * 1024, MTOK, 3072, 1024, 1024};
            pg8::StaticOrder S; S.init(MTOK, 3072, F.G, F.bid);
            pg8::EpiProj<1> E{(pg8::bf16_t*)(ws + WS_G), (pg8::bf16_t*)(ws + WS_G + G_VTC), (const float*)(ws + WS_ROPE), (const float*)(ws + WS_ROPE) + 1024, F.out + O_CK, F.out + O_CV, jl};
            pg8::gemm_phase<pg8::EpiProj<1>, pg8::StaticOrder, true, true>(F.lds, g, S, E, F.tid); }
        } else if (kind == 9) { if (EN(9)) attnC2_phase(F, jl, l); }
        else { if (EN(11)) final_norm_phase(F); }

    }
}
#ifndef MK_ONE_LAUNCH
#define MK_ONE_LAUNCH 1
#endif
extern "C" void kernel_launch(void* const* d_in, const int* in_sizes, int n_in, void* d_out, int out_size, void* d_ws, size_t ws_size, hipStream_t stream) {
    static int grid = 0;
    if (grid == 0) {
        if (n_in != 38 || (size_t)out_size != O_END || ws_size < WS_END2) { fprintf(stderr, "kernel_launch: unexpected sizes n_in %d out %d ws %zu (need %zu)\n", n_in, out_size, ws_size, (size_t)WS_END2); grid = -1; return; }
        int dev = 0, cus = 0, per = 0;
        (void)hipGetDevice(&dev); (void)hipDeviceGetAttribute(&cus, hipDeviceAttributeMultiprocessorCount, dev);
        (void)hipFuncSetAttribute((const void*)fwd_kernel, hipFuncAttributeMaxDynamicSharedMemorySize, LDS_BYTES);
        (void)hipOccupancyMaxActiveBlocksPerMultiprocessor(&per, (const void*)fwd_kernel, 512, LDS_BYTES);
        if (per < 1) { fprintf(stderr, "kernel_launch: occupancy query says %d blocks per CU\n", per); per = 1; }
        grid = cus;
        (void)hipGetLastError();
    }
    if (grid < 0) return;
    Args a{};
    for (int i = 0; i < 38; ++i) a.in[i] = (const float*)d_in[i];
    a.out = (float*)d_out; a.ws = (unsigned char*)d_ws;
#if MK_ONE_LAUNCH
    (void)hipMemsetAsync(d_ws, 0, 16384, stream);
    a.ph_lo = 0; a.ph_hi = NPHASE;
    void* kargs[] = {&a};
    hipError_t e = hipLaunchCooperativeKernel((const void*)fwd_kernel, dim3(grid), dim3(512), kargs, LDS_BYTES, stream);
    if (e != hipSuccess) fprintf(stderr, "cooperative launch failed: %s\n", hipGetErrorString(e));
#else
    for (int ph = 0; ph < NPHASE; ++ph) { a.ph_lo = ph; a.ph_hi = ph + 1; hipLaunchKernelGGL(fwd_kernel, dim3(grid), dim3(512), LDS_BYTES, stream, a); }
#endif
}
```

```cpp
#include <hip/hip_runtime.h>
#include <hip/hip_cooperative_groups.h>
#include <cstdio>
#include <cstdint>
namespace cg = cooperative_groups;

constexpr int DM = 1024, MTOK = 40960, MPR = 8192, TP = 256, TL = 4096, NSEQP = 32, NSEQL = 8;
constexpr int DFF = 2816, ABC = 2688, ABCP = 2816, CC = 3072, NMOD = 9, MODW = 9216;
constexpr int PLD_AB = 2816, PLD_C = 2048;
namespace pg8 {
#define PG8_LAS __attribute__((address_space(3)))
typedef unsigned short bf16_t;
typedef short bf16x8 __attribute__((ext_vector_type(8)));
typedef float f32x4 __attribute__((ext_vector_type(4)));
typedef unsigned u32x4 __attribute__((ext_vector_type(4)));
constexpr int BM = 256, BK = 64, HALF = 128, HTB = HALF * BK * 2  , STAGE_BYTES = 8 * HTB, NXCD = 8, WGM = 4;

__host__ __device__ __forceinline__ int lds_byte(int r, int c) { const int st = (r >> 4) * 2 + (c >> 5), rr = r & 15, cc = c & 31, ob = rr * 64 + cc * 2; return st * 1024 + (ob ^ (((ob >> 9) & 1) << 5)); }
__host__ __device__ __forceinline__ void stage_rc(int b, int& R, int& C) { const int st = b / 1024, sb = b % 1024, swz = sb ^ (((sb >> 9) & 1) << 5); R = (st >> 1) * 16 + swz / 64; C = (st & 1) * 32 + (swz % 64) / 2; }
__host__ __device__ __forceinline__ int perm32(int rho) { const int n = rho >> 4, i = rho & 15; return 8 * (i >> 2) + 4 * n + (i & 3); }

struct Unit { int pm, pn, kq; };
struct Gemm { const bf16_t* A; const bf16_t* Bt; int M, N, K, ld; };

struct StaticOrder {
    int nM, nN, nwg, G, c;
    __host__ __device__ void init(int M, int N, int G_, int c_) { nM = M / BM; nN = N / BM; nwg = nM * nN; G = G_; c = c_; }
    __host__ __device__ bool next(int i, Unit& u) const {
        const long L = (long)i * G + c; if (L >= nwg) return false;
        int wgid = (int)L; { const int q = nwg / NXCD, r = nwg % NXCD, xcd = wgid % NXCD, off = wgid / NXCD; wgid = (xcd < r ? xcd * (q + 1) : r * (q + 1) + (xcd - r) * q) + off; }
        const int nig = WGM * nN, gid = wgid / nig, fm = gid * WGM, gsz = (nM - fm) < WGM ? (nM - fm) : WGM;
        u.pm = fm + ((wgid % nig) % gsz); u.pn = (wgid % nig) / gsz; u.kq = 0; return true;
    }
    __device__ __forceinline__ void a_ready(const Unit&) const {}
    __device__ __forceinline__ void done(const Unit&) const {}
};
struct SplitOrder {
    int nM, nN, nwg, G, c;
    __host__ __device__ void init(int M, int N, int G_, int c_) { nM = M / BM; nN = N / BM; nwg = 2 * nM * nN; G = G_; c = c_; }
    __host__ __device__ bool next(int i, Unit& u) const {
        const long L = (long)i * G + c; if (L >= nwg) return false;
        int wgid = (int)L; { const int q = nwg / NXCD, r = nwg % NXCD, xcd = wgid % NXCD, off = wgid / NXCD; wgid = (xcd < r ? xcd * (q + 1) : r * (q + 1) + (xcd - r) * q) + off; }
        u.kq = wgid & 1; wgid >>= 1;
        const int nig = WGM * nN, gid = wgid / nig, fm = gid * WGM, gsz = (nM - fm) < WGM ? (nM - fm) : WGM;
        u.pm = fm + ((wgid % nig) % gsz); u.pn = (wgid % nig) / gsz; return true;
    }
    __device__ __forceinline__ void a_ready(const Unit&) const {}
    __device__ __forceinline__ void done(const Unit&) const {}
};


__device__ __forceinline__ unsigned cvt_pk_bf16(float lo, float hi) { unsigned r; asm volatile("v_cvt_pk_bf16_f32 %0, %1, %2" : "=v"(r) : "v"(lo), "v"(hi)); return r; }
typedef float f32x2 __attribute__((ext_vector_type(2)));
typedef float f32x2 __attribute__((ext_vector_type(2)));
__device__ __forceinline__ float silu_f(float x) { return x * __builtin_amdgcn_rcpf(1.0f + __builtin_amdgcn_exp2f(-1.4426950408889634f * x)); }
struct EpiSwiGLU {
    static constexpr bool PERM = true, AFTER_DRAIN = false;
    bf16_t* G;
    __device__ __forceinline__ void operator()(const f32x4 (&acc)[2][2][4][2], const Unit& u, int wr, int wc, int fr, int fq) const {
        const int row0 = u.pm * BM + wr * 64 + fr; const int col0 = u.pn * 128 + wc * 32 + 8 * fq;
#pragma unroll
        for (int ai = 0; ai < 2; ++ai)
#pragma unroll
            for (int m = 0; m < 4; ++m) {
                bf16_t* rowp = G + (size_t)(row0 + ai * HALF + m * 16) * 2816 + col0;
                const f32x4 g0 = acc[ai][0][m][0], g1 = acc[ai][0][m][1], u0 = acc[ai][1][m][0], u1 = acc[ai][1][m][1];
                u32x4 w;
                w.x = cvt_pk_bf16(silu_f(g0[0]) * u0[0], silu_f(g0[1]) * u0[1]); w.y = cvt_pk_bf16(silu_f(g0[2]) * u0[2], silu_f(g0[3]) * u0[3]);
                w.z = cvt_pk_bf16(silu_f(g1[0]) * u1[0], silu_f(g1[1]) * u1[1]); w.w = cvt_pk_bf16(silu_f(g1[2]) * u1[2], silu_f(g1[3]) * u1[3]);
                *(u32x4*)rowp = w;
            }
    }
};
template <bool ATOMIC> struct EpiResid {
    static constexpr bool PERM = false, AFTER_DRAIN = false;
    float* X; const float* gate; float scale;
    __device__ __forceinline__ void operator()(const f32x4 (&acc)[2][2][4][2], const Unit& u, int wr, int wc, int fr, int fq) const {
        const int r0 = u.pm * BM; const int cidx = (r0 < 8192) ? 8 : ((r0 - 8192) >> 12);
        const float* gp = gate + (size_t)cidx * 9216;
        const int col0 = u.pn * BM + wc * 32 + 4 * fq;
#pragma unroll
        for (int bj = 0; bj < 2; ++bj)
#pragma unroll
            for (int n = 0; n < 2; ++n) {
                const f32x4 gv = *(const f32x4*)(gp + col0 + bj * HALF + n * 16) * scale;
#pragma unroll
                for (int ai = 0; ai < 2; ++ai)
#pragma unroll
                    for (int m = 0; m < 4; ++m) {
                        float* p = X + (size_t)(r0 + ai * HALF + wr * 64 + m * 16 + fr) * 1024 + col0 + bj * HALF + n * 16;
                        if (ATOMIC) { const f32x4 dlt = gv * acc[ai][bj][m][n];
#pragma unroll
                            for (int j = 0; j < 4; ++j) unsafeAtomicAdd(p + j, dlt[j]); }
                        else { f32x4 x = *(f32x4*)p; x = x + gv * acc[ai][bj][m][n]; *(f32x4*)p = x; }
                    }
            }
    }
};
template <int MODE> struct EpiProj {
    static constexpr bool PERM = true, AFTER_DRAIN = false;
    bf16_t* P; bf16_t* Vt; const float* ropec; const float* ropes; float* outK; float* outV; int jl;
    __device__ __forceinline__ void operator()(const f32x4 (&acc)[2][2][4][2], const Unit& u, int wr, int wc, int fr, int fq) const {
        constexpr int LDP = MODE == 0 ? 2816 : 2048;
        const int r0 = u.pm * BM; const bool prompt = r0 < 8192;
#pragma unroll
        for (int bj = 0; bj < 2; ++bj) {
            const int seg = 2 * u.pn + bj;
            int kind;
            int kbase, vbase, okw;
            if (MODE == 0) { kind = seg < 4 ? 1 : seg == 4 ? 2 : seg == 5 ? 3 : seg <= 20 ? 0 : 4; kbase = 512; vbase = 640; okw = 128; }
            else { kind = seg < 8 ? 1 : seg < 16 ? 2 : 3; kbase = 1024; vbase = 2048; okw = 1024; }
            if (kind == 4) continue;
            const int cseg = seg * 128 + wc * 32 + 8 * fq;
#pragma unroll
            for (int ai = 0; ai < 2; ++ai)
#pragma unroll
                for (int m = 0; m < 4; ++m) {
                    const int r = r0 + ai * HALF + wr * 64 + m * 16 + fr;
                    f32x4 v0 = acc[ai][bj][m][0], v1 = acc[ai][bj][m][1];
                    if ((kind == 2 || kind == 3) && prompt) {
                        float* o = (kind == 2 ? outK : outV) + ((size_t)((r >> 8) * 2 + jl) * 256 + (r & 255)) * okw + (cseg - (kind == 2 ? kbase : vbase));
                        *(f32x4*)o = v0; *(f32x4*)(o + 4) = v1;
                    }
                    if ((kind == 1 || kind == 2) && !prompt) {
                        const int t = (r - 8192) & 4095; const int pos = (wc & 1) ? (t & 63) : (t >> 6);
                        const float sg = (fq < 2) ? -1.0f : 1.0f;
                        { const f32x4 c0 = *(const f32x4*)(ropec + pos * 16 + 8 * (fq & 1)), s0 = *(const f32x4*)(ropes + pos * 16 + 8 * (fq & 1)); f32x4 p0;
#pragma unroll
                          for (int j = 0; j < 4; ++j) p0[j] = __shfl_xor(v0[j], 32);
                          v0 = v0 * c0 + (p0 * s0) * sg; }
                        { const f32x4 c1 = *(const f32x4*)(ropec + pos * 16 + 8 * (fq & 1) + 4), s1 = *(const f32x4*)(ropes + pos * 16 + 8 * (fq & 1) + 4); f32x4 p1;
#pragma unroll
                          for (int j = 0; j < 4; ++j) p1[j] = __shfl_xor(v1[j], 32);
                          v1 = v1 * c1 + (p1 * s1) * sg; }
                    }
                    if (kind == 3) {
                        bf16_t* vp = Vt + (size_t)(cseg - vbase) * ::MTOK + r;
#pragma unroll
                        for (int j = 0; j < 4; ++j) { vp[(size_t)j * ::MTOK] = (bf16_t)(cvt_pk_bf16(v0[j], 0.f) & 0xffffu); vp[(size_t)(j + 4) * ::MTOK] = (bf16_t)(cvt_pk_bf16(v1[j], 0.f) & 0xffffu); }
                    } else {
                        u32x4 w; w.x = cvt_pk_bf16(v0[0], v0[1]); w.y = cvt_pk_bf16(v0[2], v0[3]); w.z = cvt_pk_bf16(v1[0], v1[1]); w.w = cvt_pk_bf16(v1[2], v1[3]);
                        *(u32x4*)(P + (size_t)r * LDP + cseg) = w;
                    }
                    asm volatile("" ::: "memory");
                }
        }
    }
};
template <class Epi, class Sched, bool ALIGN_EPI = false, bool SP2 = false>
__device__ __forceinline__ void gemm_phase(PG8_LAS unsigned char* lds, const Gemm g, const Sched& S, const Epi& E, const int tid) {
    const int wid = __builtin_amdgcn_readfirstlane(tid >> 6), lane = tid & 63, wr = wid >> 2, wc = wid & 3, fr = lane & 15, fq = lane >> 4;
    const int K = g.ld, nt = g.K / BK;
    const size_t qstep = (size_t)g.K * 2;
    unsigned voffA[2], voffB[2];
#pragma unroll
    for (int i = 0; i < 2; ++i) { int R, C; stage_rc(tid * 16 + i * 8192, R, C); const int Rb = Epi::PERM ? ((R & ~31) + perm32(R & 31)) : R;
        voffA[i] = (unsigned)(R * K + C) * 2u; voffB[i] = (unsigned)(Rb * K + C) * 2u; }
    const size_t kstep = (size_t)(BK * 2);
    const size_t hstep = (size_t)HALF * K * 2;
    const size_t tstep = 2 * hstep;
    const unsigned ldsw = (unsigned)wid * 1024u;
    const int aoff = lds_byte(wr * 64 + fr, fq * 8), boff = lds_byte(wc * 32 + fr, fq * 8);
#define PG8_SA(b, h) (((b) * 2 + (h)) * HTB)
#define PG8_SB(b, h) ((4 + (b) * 2 + (h)) * HTB)
#define PG8_STAGE(bufoff, gbase, voff) do { _Pragma("unroll") for (int _i = 0; _i < 2; ++_i) \
        __builtin_amdgcn_global_load_lds((const unsigned*)((const char*)(gbase) + (voff)[_i]), (PG8_LAS unsigned*)(lds + (bufoff) + ldsw + _i * 8192), 16, 0, 0); } while (0)
#define PG8_LDA(dst, b, h) do { _Pragma("unroll") for (int m = 0; m < 4; ++m) _Pragma("unroll") for (int k = 0; k < 2; ++k) dst[m][k] = *(const PG8_LAS bf16x8*)(lds + PG8_SA(b, h) + aoff + m * 2048 + k * 1024); } while (0)
#define PG8_LDB(dst, b, h) do { _Pragma("unroll") for (int n = 0; n < 2; ++n) _Pragma("unroll") for (int k = 0; k < 2; ++k) dst[n][k] = *(const PG8_LAS bf16x8*)(lds + PG8_SB(b, h) + boff + n * 2048 + k * 1024); } while (0)
#define PG8_MMA(ai, bj, At, Bt) do { __builtin_amdgcn_s_setprio(1); _Pragma("unroll") for (int m = 0; m < 4; ++m) _Pragma("unroll") for (int n = 0; n < 2; ++n) _Pragma("unroll") for (int k = 0; k < 2; ++k) \
        acc[ai][bj][m][n] = __builtin_amdgcn_mfma_f32_16x16x32_bf16(Bt[n][k], At[m][k], acc[ai][bj][m][n], 0, 0, 0); __builtin_amdgcn_s_setprio(0); } while (0)
#define PG8_WAIT_V(n) asm volatile("s_waitcnt vmcnt(" #n ")" ::: "memory")
#define PG8_WAIT_L(n) asm volatile("s_waitcnt lgkmcnt(" #n ")" ::: "memory")
#define PG8_BAR __builtin_amdgcn_s_barrier()
#define PG8_SCHED __builtin_amdgcn_sched_barrier(0)
    Unit cur, nxt; int ui = 0;
    float zf_ = 0.f; asm volatile("" : "+v"(zf_));
    if (!S.next(0, cur)) return;
    f32x4 acc[2][2][4][2];
#pragma unroll
    for (int a = 0; a < 2; ++a)
#pragma unroll
        for (int b = 0; b < 2; ++b)
#pragma unroll
            for (int m = 0; m < 4; ++m)
#pragma unroll
                for (int n = 0; n < 2; ++n) acc[a][b][m][n] = (f32x4){zf_, zf_, zf_, zf_};
    bf16x8 At[4][2], B0[2][2], B1[2][2];
    const char* cA = (const char*)g.A + (size_t)cur.pm * tstep + (size_t)cur.kq * qstep; const char* cB = (const char*)g.Bt + (size_t)cur.pn * tstep + (size_t)cur.kq * qstep;
    S.a_ready(cur);
    if constexpr (SP2) {
        PG8_STAGE(PG8_SB(0, 0), cB, voffB); PG8_STAGE(PG8_SB(0, 1), cB + hstep, voffB); PG8_STAGE(PG8_SA(0, 0), cA, voffA); PG8_STAGE(PG8_SA(0, 1), cA + hstep, voffA);
        if (wr == 1) PG8_BAR;
        PG8_WAIT_V(2); PG8_BAR;
        PG8_STAGE(PG8_SB(1, 0), cB + kstep, voffB); PG8_STAGE(PG8_SA(1, 0), cA + kstep, voffA); PG8_STAGE(PG8_SB(1, 1), cB + hstep + kstep, voffB);
        PG8_WAIT_V(6); PG8_BAR;
    } else {
        PG8_STAGE(PG8_SB(0, 0), cB, voffB); PG8_STAGE(PG8_SA(0, 0), cA, voffA); PG8_STAGE(PG8_SB(0, 1), cB + hstep, voffB); PG8_STAGE(PG8_SA(0, 1), cA + hstep, voffA);
        if (wr == 1) PG8_BAR;
        PG8_WAIT_V(4); PG8_BAR;
        PG8_STAGE(PG8_SB(1, 0), cB + kstep, voffB); PG8_STAGE(PG8_SA(1, 0), cA + kstep, voffA); PG8_STAGE(PG8_SB(1, 1), cB + hstep + kstep, voffB);
        PG8_WAIT_V(6); PG8_BAR;
    }
    for (;;) {
        const bool has_next = S.next(ui + 1, nxt);
        const char* nA = has_next ? (const char*)g.A + (size_t)nxt.pm * tstep + (size_t)nxt.kq * qstep : cA; const char* nB = has_next ? (const char*)g.Bt + (size_t)nxt.pn * tstep + (size_t)nxt.kq * qstep : cB;
        for (int t = 0; t < nt; t += 2) {
            const bool last = (t == nt - 2);
            const char* a1 = cA + (size_t)(t + 1) * kstep;
            const char* a2 = last ? nA : cA + (size_t)(t + 2) * kstep; const char* b2 = last ? nB : cB + (size_t)(t + 2) * kstep;
            const char* a3 = a2 + kstep; const char* b3 = b2 + kstep;
            if (last && has_next) S.a_ready(nxt);
            if constexpr (SP2) {
            PG8_LDB(B0, 0, 0); PG8_LDB(B1, 0, 1); PG8_SCHED; PG8_LDA(At, 0, 0); PG8_STAGE(PG8_SA(1, 1), a1 + hstep, voffA);
            PG8_WAIT_V(8); PG8_WAIT_L(0); PG8_BAR; PG8_MMA(0, 0, At, B0); PG8_MMA(0, 1, At, B1); PG8_BAR; PG8_SCHED;
            PG8_LDA(At, 0, 1); PG8_STAGE(PG8_SB(0, 0), b2, voffB); PG8_STAGE(PG8_SB(0, 1), b2 + hstep, voffB); PG8_STAGE(PG8_SA(0, 0), a2, voffA);
            PG8_WAIT_V(8); PG8_WAIT_L(0); PG8_BAR; PG8_MMA(1, 0, At, B0); PG8_MMA(1, 1, At, B1); PG8_BAR; PG8_SCHED;
            PG8_LDB(B0, 1, 0); PG8_LDB(B1, 1, 1); PG8_SCHED; PG8_LDA(At, 1, 0); PG8_STAGE(PG8_SA(0, 1), a2 + hstep, voffA);
            PG8_WAIT_V(8); PG8_WAIT_L(0); PG8_BAR; PG8_MMA(0, 0, At, B0); PG8_MMA(0, 1, At, B1); PG8_BAR; PG8_SCHED;
            PG8_LDA(At, 1, 1); PG8_STAGE(PG8_SB(1, 0), b3, voffB); PG8_STAGE(PG8_SB(1, 1), b3 + hstep, voffB); PG8_STAGE(PG8_SA(1, 0), a3, voffA);
            PG8_WAIT_V(8); PG8_WAIT_L(0); PG8_BAR; PG8_MMA(1, 0, At, B0); PG8_MMA(1, 1, At, B1); PG8_BAR; PG8_SCHED;
            } else {
            PG8_LDB(B0, 0, 0); PG8_SCHED; PG8_LDA(At, 0, 0); PG8_STAGE(PG8_SA(1, 1), a1 + hstep, voffA);
            PG8_WAIT_L(8); PG8_BAR; PG8_WAIT_L(0); PG8_MMA(0, 0, At, B0); PG8_BAR; PG8_SCHED;
            PG8_LDB(B1, 0, 1); PG8_STAGE(PG8_SB(0, 0), b2, voffB);
            PG8_BAR; PG8_WAIT_L(0); PG8_MMA(0, 1, At, B1); PG8_BAR;
            PG8_LDA(At, 0, 1); PG8_STAGE(PG8_SA(0, 0), a2, voffA);
            PG8_BAR; PG8_WAIT_L(0); PG8_MMA(1, 0, At, B0); PG8_BAR; PG8_SCHED;
            PG8_STAGE(PG8_SB(0, 1), b2 + hstep, voffB);
            PG8_WAIT_V(6); PG8_BAR; PG8_MMA(1, 1, At, B1); PG8_BAR;
            PG8_LDB(B0, 1, 0); PG8_SCHED; PG8_LDA(At, 1, 0); PG8_STAGE(PG8_SA(0, 1), a2 + hstep, voffA);
            PG8_WAIT_L(8); PG8_BAR; PG8_WAIT_L(0); PG8_MMA(0, 0, At, B0); PG8_BAR; PG8_SCHED;
            PG8_LDB(B1, 1, 1); PG8_STAGE(PG8_SB(1, 0), b3, voffB);
            PG8_BAR; PG8_WAIT_L(0); PG8_MMA(0, 1, At, B1); PG8_BAR;
            PG8_LDA(At, 1, 1); PG8_STAGE(PG8_SA(1, 0), a3, voffA);
            PG8_BAR; PG8_WAIT_L(0); PG8_MMA(1, 0, At, B0); PG8_BAR; PG8_SCHED;
            PG8_STAGE(PG8_SB(1, 1), b3 + hstep, voffB);
            PG8_WAIT_V(6); PG8_BAR; PG8_MMA(1, 1, At, B1); PG8_BAR;
            }
        }
        if constexpr (ALIGN_EPI) { if (wr == 0) PG8_BAR; }
        if constexpr (!Epi::AFTER_DRAIN) { E(acc, cur, wr, wc, fr, fq); S.done(cur); }
        if (!has_next) break;
#pragma unroll
        for (int a = 0; a < 2; ++a)
#pragma unroll
            for (int b = 0; b < 2; ++b)
#pragma unroll
                for (int m = 0; m < 4; ++m)
#pragma unroll
                    for (int n = 0; n < 2; ++n) acc[a][b][m][n] = (f32x4){zf_, zf_, zf_, zf_};
        cur = nxt; cA = nA; cB = nB; ++ui;
        if constexpr (ALIGN_EPI) { if (wr == 1) PG8_BAR; }
    }
    PG8_WAIT_V(0);
    if constexpr (!ALIGN_EPI) { if (wr == 0) PG8_BAR; }
    PG8_BAR;
    if constexpr (Epi::AFTER_DRAIN) { E.fused(acc, cur, wr, wc, fr, fq, lds, wid, lane); S.done(cur); }
#undef PG8_SA
#undef PG8_SB
#undef PG8_STAGE
#undef PG8_LDA
#undef PG8_LDB
#undef PG8_MMA
#undef PG8_WAIT_V
#undef PG8_WAIT_L
#undef PG8_BAR
#undef PG8_SCHED
}
}
#define LAS __attribute__((address_space(3)))
typedef unsigned short bf16;
typedef float f32x4 __attribute__((ext_vector_type(4)));
typedef float f32x16 __attribute__((ext_vector_type(16)));
typedef short bf16x8 __attribute__((ext_vector_type(8)));
typedef short s16x4 __attribute__((ext_vector_type(4)));
typedef unsigned u32x4 __attribute__((ext_vector_type(4)));
typedef unsigned u32x2 __attribute__((ext_vector_type(2)));
#define MFMA32(a, b, c) __builtin_amdgcn_mfma_f32_32x32x16_bf16((a), (b), (c), 0, 0, 0)
__device__ __forceinline__ unsigned f2bf(float f) { unsigned u = __builtin_bit_cast(unsigned, f); return (u + 0x7fffu + ((u >> 16) & 1u)) >> 16; }
typedef float f32x2_t __attribute__((ext_vector_type(2))); typedef __bf16 bf16x2_t __attribute__((ext_vector_type(2)));
__device__ __forceinline__ unsigned pk2(float lo, float hi) { const f32x2_t v = {lo, hi}; const bf16x2_t q = __builtin_convertvector(v, bf16x2_t); return __builtin_bit_cast(unsigned, q); }
__device__ __forceinline__ float bf2f(unsigned short b) { return __builtin_bit_cast(float, (unsigned)b << 16); }
__device__ __forceinline__ int crow(int reg, int h) { return (reg & 3) + 8 * (reg >> 2) + 4 * h; }
__device__ __forceinline__ float wave_sum(float v) {
#pragma unroll
    for (int o = 1; o < 64; o <<= 1) v += __shfl_xor(v, o);
    return v;
}
constexpr size_t MiB = 1u << 20;
constexpr size_t WS_MOD = 1 * MiB;
constexpr size_t WS_ROPE = 3 * MiB;
constexpr size_t WS_BC = 4 * MiB;
constexpr size_t WS_W13 = 8 * MiB;
constexpr size_t WS_W2 = WS_W13 + 88 * MiB;
constexpr size_t WS_WAB = WS_W2 + 44 * MiB;
constexpr size_t WS_WABO = WS_WAB + 11 * MiB;
constexpr size_t WS_WC = WS_WABO + 4 * MiB;
constexpr size_t WS_WCO = WS_WC + 12 * MiB;
constexpr size_t WS_KAC = WS_WCO + 4 * MiB;
constexpr size_t WS_VAC = WS_KAC + 2 * MiB;
constexpr size_t WS_KCC = WS_VAC + 2 * MiB;
constexpr size_t WS_VCC = WS_KCC + 16 * MiB;
constexpr size_t WS_H = WS_VCC + 16 * MiB;
constexpr size_t WS_Y = WS_H + 80 * MiB;
constexpr size_t WS_G = WS_Y + 80 * MiB;
constexpr size_t WS_END = WS_G + 240 * MiB;
constexpr size_t G_VTA = (size_t)MTOK * 2816 * 2;
constexpr size_t G_VTC = (size_t)MTOK * 2048 * 2;
static_assert(G_VTA + (size_t)128 * MTOK * 2 <= 240 * MiB && G_VTC + (size_t)1024 * MTOK * 2 <= 240 * MiB, "G region");

struct Args {
    const float* in[38]; float* out; unsigned char* ws; int ph_lo, ph_hi;
};
struct Frame {
    LAS unsigned char* lds; int tid, lane, wave, G, bid;
    const float* const* in; float* out; unsigned char* ws;
};
constexpr size_t O_YP = 0, O_YS = (size_t)MPR * DM, O_AK = (size_t)MTOK * DM, O_AV = O_AK + (size_t)32 * 2 * 256 * 128, O_BW = O_AV + (size_t)32 * 2 * 256 * 128,
                 O_CK = O_BW + (size_t)32 * 2 * 2 * 8 * 64 * 64, O_CV = O_CK + (size_t)32 * 2 * 256 * 1024, O_END = O_CV + (size_t)32 * 2 * 256 * 1024;
enum { I_XP = 0, I_XS, I_C, I_CCTX, I_CAK, I_CAV, I_SB, I_CCK, I_CCV, I_NORMS, I_MODW, I_MODB, I_W1, I_W3, I_W2, I_WINAB, I_WOUTAB, I_SINK, I_MUP, I_MUN,
       I_BW0, I_BW2, I_BA0, I_BA2, I_BKK, I_BKA, I_BRK, I_BG2, I_GNW, I_GNB, I_WINC, I_WOUTC, I_LQ1, I_LK1, I_LQ2, I_LK2, I_SUBLN, I_FNORM };

__device__ __forceinline__ void transpose_item(const float* W, int K, int N, bf16* WT, int k0, int n0, int drow0, LAS float* scr, int lane) {
#pragma unroll 8
    for (int i = 0; i < 32; ++i) { const int kk = 2 * i + (lane >> 5); scr[kk * 33 + (lane & 31)] = W[(size_t)(k0 + kk) * N + n0 + (lane & 31)]; }
    asm volatile("s_waitcnt lgkmcnt(0)" ::: "memory");
    const int c = lane & 7;
#pragma unroll
    for (int j = 0; j < 4; ++j) { const int n = (lane >> 3) + 8 * j; const LAS float* s = scr + (8 * c) * 33 + n;
        u32x4 o; o.x = pk2(s[0 * 33], s[1 * 33]); o.y = pk2(s[2 * 33], s[3 * 33]); o.z = pk2(s[4 * 33], s[5 * 33]); o.w = pk2(s[6 * 33], s[7 * 33]);
        *(u32x4*)(WT + (size_t)(drow0 + n) * K + k0 + 8 * c) = o; }
    asm volatile("s_waitcnt lgkmcnt(0)" ::: "memory");
}
__device__ __forceinline__ void prologue(Frame& F) {
    unsigned char* ws = F.ws;
    LAS float* scr = (LAS float*)(F.lds + F.wave * 16384);
    const int gw = F.bid * 8 + F.wave, NGW = F.G * 8;
    const int gt = F.bid * 512 + F.tid, NGT = F.G * 512;
    constexpr int IT_W1 = 16 * 88, IT_W2 = 44 * 32, IT_AB = 16 * 84, IT_SQ = 16 * 32, IT_C = 16 * 96, IT_AV = 8 * 4, IT_CV = 8 * 32;
    constexpr int E0 = 8 * IT_W1, E1 = E0 + 8 * IT_W1, E2 = E1 + 8 * IT_W2, E3 = E2 + 2 * IT_AB, E4 = E3 + 2 * IT_SQ, E5 = E4 + 2 * IT_C, E6 = E5 + 2 * IT_SQ, E7 = E6 + 16 * IT_AV, E8a = E7 + 16 * IT_CV, E8b = E8a + 4 * 16, E8 = E8b + 4 * 16;
    for (int it = gw; it < E8; it += NGW) {
        const float* W; bf16* WT; int K, N, r, mode = 0;
        if (it < E0) { r = it; const int mi = r / IT_W1; r %= IT_W1; W = F.in[I_W1] + (size_t)mi * 1024 * 2816; WT = (bf16*)(ws + WS_W13) + (size_t)mi * 5632 * 1024; K = 1024; N = 2816; mode = 1; }
        else if (it < E1) { r = it - E0; const int mi = r / IT_W1; r %= IT_W1; W = F.in[I_W3] + (size_t)mi * 1024 * 2816; WT = (bf16*)(ws + WS_W13) + (size_t)mi * 5632 * 1024; K = 1024; N = 2816; mode = 2; }
        else if (it < E2) { r = it - E1; const int mi = r / IT_W2; r %= IT_W2; W = F.in[I_W2] + (size_t)mi * 2816 * 1024; WT = (bf16*)(ws + WS_W2) + (size_t)mi * 1024 * 2816; K = 2816; N = 1024; }
        else if (it < E3) { r = it - E2; const int mi = r / IT_AB; r %= IT_AB; W = F.in[I_WINAB] + (size_t)mi * 1024 * 2688; WT = (bf16*)(ws + WS_WAB) + (size_t)mi * 2816 * 1024; K = 1024; N = 2688; }
        else if (it < E4) { r = it - E3; const int mi = r / IT_SQ; r %= IT_SQ; W = F.in[I_WOUTAB] + (size_t)mi * 1024 * 1024; WT = (bf16*)(ws + WS_WABO) + (size_t)mi * 1024 * 1024; K = 1024; N = 1024; }
        else if (it < E5) { r = it - E4; const int mi = r / IT_C; r %= IT_C; W = F.in[I_WINC] + (size_t)mi * 1024 * 3072; WT = (bf16*)(ws + WS_WC) + (size_t)mi * 3072 * 1024; K = 1024; N = 3072; }
        else if (it < E6) { r = it - E5; const int mi = r / IT_SQ; r %= IT_SQ; W = F.in[I_WOUTC] + (size_t)mi * 1024 * 1024; WT = (bf16*)(ws + WS_WCO) + (size_t)mi * 1024 * 1024; K = 1024; N = 1024; }
        else if (it < E7) { r = it - E6; const int mi = r / IT_AV; r %= IT_AV; W = F.in[I_CAV] + (size_t)mi * 512 * 128; WT = (bf16*)(ws + WS_VAC) + (size_t)mi * 128 * 512; K = 512; N = 128; }
        else if (it < E8a) { r = it - E7; const int mi = r / IT_CV; r %= IT_CV; W = F.in[I_CCV] + (size_t)mi * 512 * 1024; WT = (bf16*)(ws + WS_VCC) + (size_t)mi * 1024 * 512; K = 512; N = 1024; }
        else if (it < E8b) { r = it - E8a; const int mi = r / 16; r %= 16; W = F.in[I_BW2] + (size_t)mi * 64 * 512; WT = (bf16*)(ws + (7 * MiB)) + (size_t)mi * 512 * 64; K = 64; N = 512; }
        else { r = it - E8b; const int mi = r / 16; r %= 16; W = F.in[I_BA2] + (size_t)mi * 64 * 512; WT = (bf16*)(ws + (7 * MiB)) + (size_t)(4 + mi) * 512 * 64; K = 64; N = 512; }
        const int nblk = N / 32, kb = r / nblk, nb = r % nblk, k0 = 64 * kb, n0 = 32 * nb;
        int drow0 = n0;
        if (mode) drow0 = (n0 >> 7) * 256 + (n0 & 127) + (mode == 2 ? 128 : 0);
        transpose_item(W, K, N, WT, k0, n0, drow0, scr, F.lane);
    }
    unsigned z_ = 0u; asm volatile("" : "+v"(z_));
    for (int i = gt; i < 2 * 128 * 1024 / 8; i += NGT) { const int mi = i / (128 * 1024 / 8), o = i % (128 * 1024 / 8);
        *(u32x4*)((bf16*)(ws + WS_WAB) + (size_t)mi * 2816 * 1024 + (size_t)2688 * 1024 + (size_t)o * 8) = (u32x4){z_, z_, z_, z_}; }
    for (int i = gt; i < 8 * 2 * 512 * 128 / 4; i += NGT) { const f32x4 v = ((const f32x4*)F.in[I_CAK])[i]; ((u32x2*)(ws + WS_KAC))[i] = (u32x2){pk2(v[0], v[1]), pk2(v[2], v[3])}; }
    for (int i = gt; i < 8 * 2 * 512 * 1024 / 4; i += NGT) { const f32x4 v = ((const f32x4*)F.in[I_CCK])[i]; ((u32x2*)(ws + WS_KCC))[i] = (u32x2){pk2(v[0], v[1]), pk2(v[2], v[3])}; }
    if (gt < 1024) { const int pos = gt >> 4, i = gt & 15; const float inv = powf(10000.0f, -(float)i / 16.0f); const float ang = (float)pos * inv;
        ((float*)(ws + WS_ROPE))[gt] = cosf(ang); ((float*)(ws + WS_ROPE))[1024 + gt] = sinf(ang); }
    __syncthreads();
    LAS float* sc = (LAS float*)F.lds;
    LAS float* red = sc + 9 * 1024;
    for (int i = F.tid; i < 9 * 1024; i += 512) { const float v = i < 8192 ? F.in[I_C][i] : F.in[I_CCTX][i - 8192]; sc[i] = v / (1.0f + __expf(-v)); }
    __syncthreads();
    for (int it = F.bid; it < 4 * 144; it += F.G) {
        const int l = it / 144, n0 = (it % 144) * 64;
        const float* W = F.in[I_MODW] + (size_t)l * 1024 * 9216 + n0 + F.lane;
        float a[9];
#pragma unroll
        for (int c = 0; c < 9; ++c) a[c] = 0.f;
        const int kb = F.wave * 128;
#pragma unroll 16
        for (int k = 0; k < 128; ++k) { const float w = W[(size_t)(kb + k) * 9216];
#pragma unroll
            for (int c = 0; c < 9; ++c) a[c] += sc[c * 1024 + kb + k] * w; }
#pragma unroll
        for (int c = 0; c < 9; ++c) red[(F.wave * 9 + c) * 64 + F.lane] = a[c];
        __syncthreads();
        for (int i = F.tid; i < 576; i += 512) { const int c = i >> 6, n = i & 63; float s = F.in[I_MODB][(size_t)l * 9216 + n0 + n];
#pragma unroll
            for (int w = 0; w < 8; ++w) s += red[(w * 9 + c) * 64 + n];
            ((float*)(ws + WS_MOD))[((size_t)l * 9 + c) * 9216 + n0 + n] = s; }
        __syncthreads();
    }
}
__device__ __forceinline__ void norm_phase(Frame& F, int l, int s) {
    const float* g = F.in[I_NORMS] + (size_t)(l * 3 + s) * 1024;
    const float* mod = (const float*)(F.ws + WS_MOD) + (size_t)l * 9 * 9216;
    bf16* H = (bf16*)(F.ws + WS_H);
    const int gw = F.bid * 8 + F.wave, NGW = F.G * 8;
    for (int m2 = gw; m2 < MTOK / 2; m2 += NGW) {
        const int m = 2 * m2;
        const int cidx = m < MPR ? 8 : ((m - MPR) >> 12);
        const float* sh = mod + (size_t)cidx * 9216 + (3 * s) * 1024; const float* scp = sh + 1024;
        const bool first = (l == 0 && s == 0);
        const float* xsrc = first ? (m < MPR ? F.in[I_XP] + (size_t)m * 1024 : F.in[I_XS] + (size_t)(m - MPR) * 1024) : F.out + (size_t)m * 1024;
        const f32x4* xr = (const f32x4*)xsrc + F.lane;
        f32x4 v[8]; float ss0 = 0.f, ss1 = 0.f;
#pragma unroll
        for (int j = 0; j < 8; ++j) v[j] = xr[64 * j];
        if (first) { f32x4* xo = (f32x4*)(F.out + (size_t)m * 1024) + F.lane;
#pragma unroll
            for (int j = 0; j < 8; ++j) xo[64 * j] = v[j]; }
#pragma unroll
        for (int j = 0; j < 4; ++j) { ss0 += (v[j].x * v[j].x + v[j].y * v[j].y) + (v[j].z * v[j].z + v[j].w * v[j].w); ss1 += (v[4 + j].x * v[4 + j].x + v[4 + j].y * v[4 + j].y) + (v[4 + j].z * v[4 + j].z + v[4 + j].w * v[4 + j].w); }
        const float rstd0 = 1.0f / sqrtf(wave_sum(ss0) * (1.0f / 1024.0f) + 1e-6f), rstd1 = 1.0f / sqrtf(wave_sum(ss1) * (1.0f / 1024.0f) + 1e-6f);
        u32x2* o = (u32x2*)(H + (size_t)m * 1024) + F.lane;
#pragma unroll
        for (int j = 0; j < 4; ++j) { const int c = 4 * F.lane + 256 * j; const f32x4 gg = *(const f32x4*)(g + c), s4 = *(const f32x4*)(scp + c) + 1.0f, h4 = *(const f32x4*)(sh + c);
            const f32x4 y0 = (v[j] * rstd0) * gg * s4 + h4, y1 = (v[4 + j] * rstd1) * gg * s4 + h4;
            o[64 * j] = (u32x2){pk2(y0.x, y0.y), pk2(y0.z, y0.w)}; o[256 + 64 * j] = (u32x2){pk2(y1.x, y1.y), pk2(y1.z, y1.w)}; }
    }
}
__device__ __forceinline__ void final_norm_phase(Frame& F) {
    const float* g = F.in[I_FNORM];
    const int gw = F.bid * 8 + F.wave, NGW = F.G * 8;
    for (int m = gw; m < MTOK; m += NGW) {
        f32x4* xr = (f32x4*)(F.out + (size_t)m * 1024) + F.lane;
        f32x4 v[4]; float ss = 0.f;
#pragma unroll
        for (int j = 0; j < 4; ++j) { v[j] = xr[64 * j]; ss += (v[j].x * v[j].x + v[j].y * v[j].y) + (v[j].z * v[j].z + v[j].w * v[j].w); }
        const float rstd = 1.0f / sqrtf(wave_sum(ss) * (1.0f / 1024.0f) + 1e-6f);
#pragma unroll
        for (int j = 0; j < 4; ++j) { const int c = 4 * F.lane + 256 * j; xr[64 * j] = (v[j] * rstd) * *(const f32x4*)(g + c); }
    }
}
struct KSeg { const bf16* K; long ks; const bf16* Vt; long vs; int k_lo, k_hi; int win; };
template <int NMAP, int DV>
struct AttnState { f32x16 o[NMAP][DV / 32]; float m[NMAP], l[NMAP]; };

template <int NMAP, int DV, bool QL>
__device__ __forceinline__ void attn_seg(AttnState<NMAP, DV>& st, const bf16x8 (&qf)[NMAP][4], const LAS bf16x8* ql, const KSeg& sg, int q0, int lane) {
    const int r = lane & 31, h = lane >> 5;
    constexpr float SC = 0.125f * 1.4426950408889634f;
    for (int k0 = sg.k_lo; k0 < sg.k_hi; k0 += 32) {
        bf16x8 pf[NMAP][2];
#pragma unroll
        for (int mp = 0; mp < NMAP; ++mp) {
            const bf16* kp = sg.K + (long)(k0 + r) * sg.ks + mp * 64 + 8 * h;
            f32x16 s;
#pragma unroll
            for (int i = 0; i < 16; ++i) s[i] = 0.f;
#pragma unroll
            for (int ks = 0; ks < 4; ++ks) { const bf16x8 kf = *(const bf16x8*)(kp + 16 * ks); const bf16x8 qv = QL ? ql[(mp * 4 + ks) * 64 + lane] : qf[mp][ks]; s = MFMA32(kf, qv, s); }
            float mx = -INFINITY;
#pragma unroll
            for (int i = 0; i < 16; ++i) { float v = s[i] * SC;
                if (sg.win) { const int d = k0 + crow(i, h) - (q0 + r); if (d > 128 || d < -128) v = -INFINITY; }
                s[i] = v; mx = fmaxf(mx, v); }
            mx = fmaxf(mx, __shfl_xor(mx, 32));
            const float mn = fmaxf(st.m[mp], mx); const float ms = (mn == -INFINITY) ? 0.f : mn;
            const float alpha = __builtin_amdgcn_exp2f(st.m[mp] - ms);
            st.m[mp] = mn;
            float ps = 0.f;
#pragma unroll
            for (int i = 0; i < 16; ++i) { s[i] = __builtin_amdgcn_exp2f(s[i] - ms); ps += s[i]; }
            st.l[mp] = st.l[mp] * alpha + ps;
#pragma unroll
            for (int dt = 0; dt < DV / 32; ++dt)
#pragma unroll
                for (int i = 0; i < 16; ++i) st.o[mp][dt][i] *= alpha;
#pragma unroll
            for (int s2 = 0; s2 < 2; ++s2) { u32x4 w; w.x = pk2(s[8 * s2], s[8 * s2 + 1]); w.y = pk2(s[8 * s2 + 2], s[8 * s2 + 3]); w.z = pk2(s[8 * s2 + 4], s[8 * s2 + 5]); w.w = pk2(s[8 * s2 + 6], s[8 * s2 + 7]);
                pf[mp][s2] = __builtin_bit_cast(bf16x8, w); }
            asm volatile("" ::: "memory");
        }
#pragma unroll
        for (int dt = 0; dt < DV / 32; ++dt) {
            const bf16* vp = sg.Vt + (long)(dt * 32 + r) * sg.vs + k0 + 4 * h;
#pragma unroll
            for (int s2 = 0; s2 < 2; ++s2) {
                const s16x4 lo = *(const s16x4*)(vp + 16 * s2), hi = *(const s16x4*)(vp + 16 * s2 + 8);
                const bf16x8 vf = __builtin_shufflevector(lo, hi, 0, 1, 2, 3, 4, 5, 6, 7);
#pragma unroll
                for (int mp = 0; mp < NMAP; ++mp) st.o[mp][dt] = MFMA32(vf, pf[mp][s2], st.o[mp][dt]);
            }
            asm volatile("" ::: "memory");
        }
    }
}
template <int NMAP, int DV>
__device__ __forceinline__ void attn_init(AttnState<NMAP, DV>& st) {
#pragma unroll
    for (int mp = 0; mp < NMAP; ++mp) { st.m[mp] = -INFINITY; st.l[mp] = 0.f;
#pragma unroll
        for (int dt = 0; dt < DV / 32; ++dt)
#pragma unroll
            for (int i = 0; i < 16; ++i) st.o[mp][dt][i] = 0.f; }
}
__device__ __forceinline__ void load_q(bf16x8 (&qf)[4], const bf16* q, int lane) {
#pragma unroll
    for (int ks = 0; ks < 4; ++ks) qf[ks] = *(const bf16x8*)(q + 16 * ks + 8 * (lane >> 5));
}
__device__ __forceinline__ bf16x8 pack8a(const f32x16& x, int s2) {
    u32x4 w; w.x = pk2(x[8 * s2], x[8 * s2 + 1]); w.y = pk2(x[8 * s2 + 2], x[8 * s2 + 3]); w.z = pk2(x[8 * s2 + 4], x[8 * s2 + 5]); w.w = pk2(x[8 * s2 + 6], x[8 * s2 + 7]);
    return __builtin_bit_cast(bf16x8, w);
}
__device__ __forceinline__ void attn_segA(AttnState<1, 64>& st, const bf16x8 (&qf)[4], const KSeg& sg, int q0, int lane) {
    const int r = lane & 31, h = lane >> 5;
    constexpr float SC = 0.125f * 1.4426950408889634f;
    if (sg.k_lo >= sg.k_hi) return;
    bf16x8 kf[4]; s16x4 vlo[2][2], vhi[2][2];
#define A_LOAD(K0) do { const bf16* kp_ = sg.K + (long)((K0) + r) * sg.ks + 8 * h; \
        _Pragma("unroll") for (int ks = 0; ks < 4; ++ks) kf[ks] = *(const bf16x8*)(kp_ + 16 * ks); \
        _Pragma("unroll") for (int dt = 0; dt < 2; ++dt) { const bf16* vp_ = sg.Vt + (long)(dt * 32 + r) * sg.vs + (K0) + 4 * h; \
            _Pragma("unroll") for (int s2 = 0; s2 < 2; ++s2) { vlo[dt][s2] = *(const s16x4*)(vp_ + 16 * s2); vhi[dt][s2] = *(const s16x4*)(vp_ + 16 * s2 + 8); } } } while (0)
    A_LOAD(sg.k_lo);
    for (int k0 = sg.k_lo; k0 < sg.k_hi; k0 += 32) {
        bf16x8 kc[4]; s16x4 cl[2][2], ch[2][2];
#pragma unroll
        for (int ks = 0; ks < 4; ++ks) kc[ks] = kf[ks];
#pragma unroll
        for (int dt = 0; dt < 2; ++dt)
#pragma unroll
            for (int s2 = 0; s2 < 2; ++s2) { cl[dt][s2] = vlo[dt][s2]; ch[dt][s2] = vhi[dt][s2]; }
        if (k0 + 32 < sg.k_hi) A_LOAD(k0 + 32);
        f32x16 s;
#pragma unroll
        for (int i = 0; i < 16; ++i) s[i] = 0.f;
#pragma unroll
        for (int ks = 0; ks < 4; ++ks) s = MFMA32(kc[ks], qf[ks], s);
        float mx = -INFINITY;
#pragma unroll
        for (int i = 0; i < 16; ++i) { float v = s[i] * SC;
            if (sg.win) { const int d = k0 + crow(i, h) - (q0 + r); if (d > 128 || d < -128) v = -INFINITY; }
            s[i] = v; mx = fmaxf(mx, v); }
        mx = fmaxf(mx, __shfl_xor(mx, 32));
        const float mn = fmaxf(st.m[0], mx); const float ms = (mn == -INFINITY) ? 0.f : mn;
        const float alpha = __builtin_amdgcn_exp2f(st.m[0] - ms);
        st.m[0] = mn;
        float ps = 0.f;
#pragma unroll
        for (int i = 0; i < 16; ++i) { s[i] = __builtin_amdgcn_exp2f(s[i] - ms); ps += s[i]; }
        st.l[0] = st.l[0] * alpha + ps;
#pragma unroll
        for (int dt = 0; dt < 2; ++dt)
#pragma unroll
            for (int i = 0; i < 16; ++i) st.o[0][dt][i] *= alpha;
        const bf16x8 p0 = pack8a(s, 0), p1 = pack8a(s, 1);
#pragma unroll
        for (int dt = 0; dt < 2; ++dt) {
            st.o[0][dt] = MFMA32(__builtin_shufflevector(cl[dt][0], ch[dt][0], 0, 1, 2, 3, 4, 5, 6, 7), p0, st.o[0][dt]);
            st.o[0][dt] = MFMA32(__builtin_shufflevector(cl[dt][1], ch[dt][1], 0, 1, 2, 3, 4, 5, 6, 7), p1, st.o[0][dt]);
        }
    }
#undef A_LOAD
}
__device__ __forceinline__ void attnA_phase(Frame& F, int jl) {
    const bf16* P = (const bf16*)(F.ws + WS_G); const bf16* VtA = (const bf16*)(F.ws + WS_G + G_VTA);
    bf16* O = (bf16*)(F.ws + WS_H);
    const int lane = F.lane, r = lane & 31, h = lane >> 5;
    constexpr int NU_L = 8 * 8 * 128, NU_P = 32 * 8 * 8;
    const bool part = (F.G == 256); const int xcd = F.bid & 7;
    unsigned* ctr = (unsigned*)F.ws + 3600 + 16 * (jl * 8 + (part ? xcd : 0));
    const int nunits = part ? 1280 : NU_L + NU_P;
    for (;;) {
        unsigned ug = 0; if (lane == 0) ug = atomicAdd(ctr, 1u);
        const int u = (int)__builtin_amdgcn_readfirstlane(ug);
        if (u >= nunits) break;
        int m0, T, head, qb, b; bool latent;
        if (part) { latent = u < 1024;
            if (latent) { b = xcd; head = u >> 7; qb = u & 127; m0 = MPR + b * TL; T = TL; }
            else { const int v = u - 1024; b = 4 * xcd + (v >> 6); head = (v >> 3) & 7; qb = v & 7; m0 = b * TP; T = TP; } }
        else { latent = u < NU_L;
            if (latent) { b = u >> 10; head = (u >> 7) & 7; qb = u & 127; m0 = MPR + b * TL; T = TL; }
            else { const int v = u - NU_L; b = v >> 6; head = (v >> 3) & 7; qb = v & 7; m0 = b * TP; T = TP; } }
        const int q0 = qb * 32, kvh = head >> 2;
        bf16x8 qf[1][4]; load_q(qf[0], P + (size_t)(m0 + q0 + r) * PLD_AB + head * 64, lane);
        AttnState<1, 64> st; attn_init(st);
        KSeg s1; s1.K = P + (size_t)m0 * PLD_AB + 512 + kvh * 64; s1.ks = PLD_AB; s1.Vt = VtA + (size_t)(kvh * 64) * MTOK + m0; s1.vs = MTOK;
        if (latent) {
            KSeg s0; s0.K = (const bf16*)(F.ws + WS_KAC) + (size_t)(b * 2 + jl) * 512 * 128 + kvh * 64; s0.ks = 128;
            s0.Vt = (const bf16*)(F.ws + WS_VAC) + (size_t)(b * 2 + jl) * 128 * 512 + (size_t)(kvh * 64) * 512; s0.vs = 512; s0.k_lo = 0; s0.k_hi = 512; s0.win = 0;
            attn_segA(st, qf[0], s0, q0, lane);
            s1.k_lo = q0 - 128 < 0 ? 0 : q0 - 128; s1.k_hi = q0 + 160 > T ? T : q0 + 160; s1.win = 1;
        } else { s1.k_lo = 0; s1.k_hi = T; s1.win = 0; }
        attn_segA(st, qf[0], s1, q0, lane);
        float l = st.l[0] + __shfl_xor(st.l[0], 32);
        l += __builtin_amdgcn_exp2f(F.in[I_SINK][jl * 8 + head] * 1.4426950408889634f - st.m[0]);
        const float rl = 1.0f / l;
        bf16* op = O + (size_t)(m0 + q0 + r) * 1024 + head * 64;
#pragma unroll
        for (int dt = 0; dt < 2; ++dt)
#pragma unroll
            for (int g = 0; g < 4; ++g) { const int d = dt * 32 + 8 * g + 4 * h;
                *(u32x2*)(op + d) = (u32x2){pk2(st.o[0][dt][4 * g] * rl, st.o[0][dt][4 * g + 1] * rl), pk2(st.o[0][dt][4 * g + 2] * rl, st.o[0][dt][4 * g + 3] * rl)}; }
    }
}
__device__ __forceinline__ void attnC_phase(Frame& F, int jl, int layer) {
    const bf16* P = (const bf16*)(F.ws + WS_G); const bf16* VtC = (const bf16*)(F.ws + WS_G + G_VTC);
    bf16* O = (bf16*)(F.ws + WS_H);
    const int lane = F.lane, r = lane & 31, h = lane >> 5;
    const int wk = F.bid * 8 + F.wave, nwk = F.G * 8;
    const float lam_init = 0.8f - 0.6f * expf(-0.3f * (float)layer);
    const float d1 = wave_sum(F.in[I_LQ1][jl * 64 + lane] * F.in[I_LK1][jl * 64 + lane]), d2 = wave_sum(F.in[I_LQ2][jl * 64 + lane] * F.in[I_LK2][jl * 64 + lane]);
    const float lam = expf(d1) - expf(d2) + lam_init;
    const float* subln = F.in[I_SUBLN] + jl * 128;
    LAS bf16x8* ql = (LAS bf16x8*)(F.lds + F.wave * 8192);
    constexpr int NU_L = 8 * 8 * 128, NU_P = 32 * 8 * 8;
    for (int u = wk; u < NU_L + NU_P; u += nwk) {
        int m0, T, head, qb, b; bool latent = u < NU_L;
        if (latent) { b = u >> 10; head = (u >> 7) & 7; qb = u & 127; m0 = MPR + b * TL; T = TL; }
        else { const int v = u - NU_L; b = v >> 6; head = (v >> 3) & 7; qb = v & 7; m0 = b * TP; T = TP; }
        const int q0 = qb * 32;
        bf16x8 qf[2][4];
        { bf16x8 qt[4]; load_q(qt, P + (size_t)(m0 + q0 + r) * PLD_C + head * 128, lane);
#pragma unroll
          for (int ks = 0; ks < 4; ++ks) ql[ks * 64 + lane] = qt[ks];
          load_q(qt, P + (size_t)(m0 + q0 + r) * PLD_C + head * 128 + 64, lane);
#pragma unroll
          for (int ks = 0; ks < 4; ++ks) ql[(4 + ks) * 64 + lane] = qt[ks]; }
        asm volatile("s_waitcnt lgkmcnt(0)" ::: "memory");
        AttnState<2, 128> st; attn_init(st);
        if (latent) {
            KSeg s0; s0.K = (const bf16*)(F.ws + WS_KCC) + (size_t)(b * 2 + jl) * 512 * 1024 + head * 128; s0.ks = 1024;
            s0.Vt = (const bf16*)(F.ws + WS_VCC) + (size_t)(b * 2 + jl) * 1024 * 512 + (size_t)(head * 128) * 512; s0.vs = 512; s0.k_lo = 0; s0.k_hi = 512; s0.win = 0;
            attn_seg<2, 128, true>(st, qf, ql, s0, q0, lane);
        }
        KSeg s1; s1.K = P + (size_t)m0 * PLD_C + 1024 + head * 128; s1.ks = PLD_C; s1.Vt = VtC + (size_t)(head * 128) * MTOK + m0; s1.vs = MTOK; s1.k_lo = 0; s1.k_hi = T; s1.win = 0;
        attn_seg<2, 128, true>(st, qf, ql, s1, q0, lane);
        const float l1 = st.l[0] + __shfl_xor(st.l[0], 32), l2 = st.l[1] + __shfl_xor(st.l[1], 32);
        const float r1 = 1.0f / l1, r2 = lam / l2;
        float ss = 0.f;
#pragma unroll
        for (int dt = 0; dt < 4; ++dt)
#pragma unroll
            for (int i = 0; i < 16; ++i) { const float v = st.o[0][dt][i] * r1 - st.o[1][dt][i] * r2; st.o[0][dt][i] = v; ss += v * v; }
        ss += __shfl_xor(ss, 32);
        const float rs = (1.0f / sqrtf(ss * (1.0f / 128.0f) + 1e-5f)) * (1.0f - lam_init);
        bf16* op = O + (size_t)(m0 + q0 + r) * 1024 + head * 128;
#pragma unroll
        for (int dt = 0; dt < 4; ++dt)
#pragma unroll
            for (int g = 0; g < 4; ++g) { const int d = dt * 32 + 8 * g + 4 * h; const f32x4 w = *(const f32x4*)(subln + d);
                *(u32x2*)(op + d) = (u32x2){pk2(st.o[0][dt][4 * g] * rs * w[0], st.o[0][dt][4 * g + 1] * rs * w[1]), pk2(st.o[0][dt][4 * g + 2] * rs * w[2], st.o[0][dt][4 * g + 3] * rs * w[3])}; }
    }
}
__device__ __forceinline__ bf16x8 pack8(const f32x16& x, int s2) {
    u32x4 w; w.x = pk2(x[8 * s2], x[8 * s2 + 1]); w.y = pk2(x[8 * s2 + 2], x[8 * s2 + 3]); w.z = pk2(x[8 * s2 + 4], x[8 * s2 + 5]); w.w = pk2(x[8 * s2 + 6], x[8 * s2 + 7]);
    return __builtin_bit_cast(bf16x8, w);
}
constexpr int KP = 136, VP = 36;
constexpr int C2_Q = 0, C2_K = 65536, C2_V = C2_K + 2 * 32 * KP * 2, C2_END = C2_V + 2 * 128 * VP * 2;
static_assert(C2_END <= 147456, "attnC2 LDS");
__device__ __forceinline__ void attnC2_phase(Frame& F, int jl, int layer) {
    const bf16* P = (const bf16*)(F.ws + WS_G); const bf16* VtC = (const bf16*)(F.ws + WS_G + G_VTC);
    bf16* O = (bf16*)(F.ws + WS_H);
    const float lam_init = 0.8f - 0.6f * expf(-0.3f * (float)layer);
    const float d1 = wave_sum(F.in[I_LQ1][jl * 64 + F.lane] * F.in[I_LK1][jl * 64 + F.lane]), d2 = wave_sum(F.in[I_LQ2][jl * 64 + F.lane] * F.in[I_LK2][jl * 64 + F.lane]);
    const float lam = expf(d1) - expf(d2) + lam_init;
    const float* subln = F.in[I_SUBLN] + jl * 128;
    LAS bf16x8* ql = (LAS bf16x8*)(F.lds + C2_Q + F.wave * 8192);
    constexpr float SC = 0.125f * 1.4426950408889634f;
    for (int u0 = F.bid; u0 < 1280; u0 += F.G) {
        int u = u0;
        if (F.G == 256 && u0 < 1024) { const int k = u0 >> 8, xcd = F.bid & 7, slot = F.bid >> 3; u = ((k * 16 + xcd * 2 + (slot >> 4)) << 4) + (slot & 15); }
        int lane = F.lane; asm volatile("" : "+v"(lane));
        const int tid = F.wave * 64 + lane, r = lane & 31, h = lane >> 5;
        int m0, T, head, b, qb; const bool latent = u < 1024;
        if (latent) { b = u >> 7; head = (u >> 4) & 7; qb = u & 15; m0 = MPR + b * TL; T = TL; } else { const int v = u - 1024; b = v >> 3; head = v & 7; qb = 0; m0 = b * TP; T = TP; }
        const int q0 = qb * 256 + F.wave * 32;
        bf16x8 qf0[4];
        load_q(qf0, P + (size_t)(m0 + q0 + r) * PLD_C + head * 128, lane);
        { bf16x8 qt[4]; load_q(qt, P + (size_t)(m0 + q0 + r) * PLD_C + head * 128 + 64, lane);
#pragma unroll
          for (int ks = 0; ks < 4; ++ks) ql[ks * 64 + lane] = qt[ks]; }
        AttnState<2, 128> st; attn_init(st);
        const int nctx = latent ? 16 : 0, ntile = nctx + T / 32;
        const bf16* kc = (const bf16*)(F.ws + WS_KCC) + (size_t)(b * 2 + jl) * 512 * 1024 + head * 128 + (size_t)(tid >> 4) * 1024 + (tid & 15) * 8;
        const bf16* vc = (const bf16*)(F.ws + WS_VCC) + (size_t)(b * 2 + jl) * 1024 * 512 + (size_t)(head * 128 + (tid >> 2)) * 512 + (tid & 3) * 8;
        const bf16* kl = P + (size_t)m0 * PLD_C + 1024 + head * 128 + (size_t)(tid >> 4) * PLD_C + (tid & 15) * 8;
        const bf16* vl = VtC + (size_t)(head * 128 + (tid >> 2)) * MTOK + m0 + (tid & 3) * 8;
        const int kw = (tid >> 4) * KP + (tid & 15) * 8, vw = (tid >> 2) * VP + (tid & 3) * 8;
        u32x4 kreg, vreg;
#define C2_LOAD(ti) do { if ((ti) < nctx) { kreg = *(const u32x4*)(kc + (size_t)(ti) * 32 * 1024); vreg = *(const u32x4*)(vc + (ti) * 32); } \
                         else { const int k0_ = ((ti) - nctx) * 32; kreg = *(const u32x4*)(kl + (size_t)k0_ * PLD_C); vreg = *(const u32x4*)(vl + k0_); } } while (0)
#define C2_STORE(bufi) do { *(LAS u32x4*)((LAS bf16*)(F.lds + C2_K) + (bufi) * 32 * KP + kw) = kreg; *(LAS u32x2*)((LAS bf16*)(F.lds + C2_V) + (bufi) * 128 * VP + vw) = (u32x2){vreg.x, vreg.y}; *(LAS u32x2*)((LAS bf16*)(F.lds + C2_V) + (bufi) * 128 * VP + vw + 4) = (u32x2){vreg.z, vreg.w}; } while (0)
        C2_LOAD(0); C2_STORE(0);
        asm volatile("s_waitcnt vmcnt(0) lgkmcnt(0)" ::: "memory"); __builtin_amdgcn_s_barrier(); asm volatile("" ::: "memory");
        for (int ti = 0; ti < ntile; ++ti) {
            const bool more = ti + 1 < ntile;
            if (more) C2_LOAD(ti + 1);
            const LAS bf16* Kb = (const LAS bf16*)(F.lds + C2_K) + (ti & 1) * 32 * KP; const LAS bf16* Vb = (const LAS bf16*)(F.lds + C2_V) + (ti & 1) * 128 * VP;
            bf16x8 pf[2][2];
#pragma unroll
            for (int mp = 0; mp < 2; ++mp) {
                f32x16 s;
#pragma unroll
                for (int i = 0; i < 16; ++i) s[i] = 0.f;
#pragma unroll
                for (int ks = 0; ks < 4; ++ks) { const bf16x8 kf = *(const LAS bf16x8*)(Kb + r * KP + mp * 64 + 16 * ks + 8 * h); s = MFMA32(kf, mp == 0 ? qf0[ks] : ql[ks * 64 + lane], s); }
                float mx = -INFINITY;
#pragma unroll
                for (int i = 0; i < 16; ++i) mx = fmaxf(mx, s[i]);
                mx = fmaxf(mx, __shfl_xor(mx, 32)) * SC;
                const float mn = (mx > st.m[mp] + 8.0f) ? mx : st.m[mp];
                const float alpha = __builtin_amdgcn_exp2f(st.m[mp] - mn);
                st.m[mp] = mn;
                float ps = 0.f;
#pragma unroll
                for (int i = 0; i < 16; ++i) { s[i] = __builtin_amdgcn_exp2f(__builtin_fmaf(s[i], SC, -mn)); ps += s[i]; }
                st.l[mp] = st.l[mp] * alpha + ps;
                if (__any(alpha != 1.0f)) {
#pragma unroll
                    for (int dt = 0; dt < 4; ++dt)
#pragma unroll
                        for (int i = 0; i < 16; ++i) st.o[mp][dt][i] *= alpha; }
                pf[mp][0] = pack8(s, 0); pf[mp][1] = pack8(s, 1);
                asm volatile("" ::: "memory");
            }
#pragma unroll
            for (int dt = 0; dt < 4; ++dt) {
#pragma unroll
                for (int s2 = 0; s2 < 2; ++s2) {
                    const LAS bf16* vp = Vb + (dt * 32 + r) * VP + 16 * s2 + 4 * h;
                    const s16x4 lo = *(const LAS s16x4*)vp, hi = *(const LAS s16x4*)(vp + 8);
                    const bf16x8 vf = __builtin_shufflevector(lo, hi, 0, 1, 2, 3, 4, 5, 6, 7);
                    st.o[0][dt] = MFMA32(vf, pf[0][s2], st.o[0][dt]); st.o[1][dt] = MFMA32(vf, pf[1][s2], st.o[1][dt]);
                }
                asm volatile("" ::: "memory");
            }
            if (more) C2_STORE((ti + 1) & 1);
            asm volatile("s_waitcnt vmcnt(0) lgkmcnt(0)" ::: "memory"); __builtin_amdgcn_s_barrier(); asm volatile("" ::: "memory");
        }
#undef C2_LOAD
#undef C2_STORE
        const float l1 = st.l[0] + __shfl_xor(st.l[0], 32), l2 = st.l[1] + __shfl_xor(st.l[1], 32);
        const float r1 = 1.0f / l1, r2 = lam / l2;
        float ss = 0.f;
#pragma unroll
        for (int dt = 0; dt < 4; ++dt)
#pragma unroll
            for (int i = 0; i < 16; ++i) { const float v = st.o[0][dt][i] * r1 - st.o[1][dt][i] * r2; st.o[0][dt][i] = v; ss += v * v; }
        ss += __shfl_xor(ss, 32);
        const float rs = (1.0f / sqrtf(ss * (1.0f / 128.0f) + 1e-5f)) * (1.0f - lam_init);
        bf16* op = O + (size_t)(m0 + q0 + r) * 1024 + head * 128;
#pragma unroll
        for (int dt = 0; dt < 4; ++dt)
#pragma unroll
            for (int g = 0; g < 4; ++g) { const int d = dt * 32 + 8 * g + 4 * h; const f32x4 w = *(const f32x4*)(subln + d);
                *(u32x2*)(op + d) = (u32x2){pk2(st.o[0][dt][4 * g] * rs * w[0], st.o[0][dt][4 * g + 1] * rs * w[1]), pk2(st.o[0][dt][4 * g + 2] * rs * w[2], st.o[0][dt][4 * g + 3] * rs * w[3])}; }
    }
}
__device__ __forceinline__ float shift3(const bf16* p, long pitch, bool hp, bool hn, float mup, float mun) {
    const float c = bf2f(p[0]); const float pv = hp ? bf2f(p[-pitch]) : 0.f; const float nx = hn ? bf2f(p[pitch]) : 0.f;
    return c + mup * (pv - c) + mun * (nx - c);
}
__device__ __forceinline__ float sigmoid_f(float x) { return __builtin_amdgcn_rcpf(1.0f + __builtin_amdgcn_exp2f(-1.4426950408889634f * x)); }
__device__ __forceinline__ float tanh_f(float x) { const float e = __builtin_amdgcn_exp2f(2.8853900817779268f * fminf(fmaxf(x, -15.f), 15.f)); return 1.0f - 2.0f * __builtin_amdgcn_rcpf(e + 1.0f); }
__device__ __forceinline__ void rwkv_scan_phase(Frame& F, int jl) {
    const int it = F.wave * F.G + F.bid;
    if (F.wave >= 3 || it >= 640) return;
    LAS float* vec = (LAS float*)(F.lds + F.wave * 20480);
    LAS float* twl = vec + 6 * 8 * 64;
    LAS float* adl = twl + 8 * 64;
    int b, h, d, T, m0; const bool latent = it < 128;
    if (latent) { b = it >> 4; h = (it >> 1) & 7; d = it & 1; T = TL; m0 = MPR + b * TL; }
    else { const int p = it - 128; b = p >> 4; h = (p >> 1) & 7; d = p & 1; T = TP; m0 = b * TP; }
    const bf16* P = (const bf16*)(F.ws + WS_G);
    bf16* Yd = (bf16*)(F.ws + WS_Y) + (size_t)d * MTOK * 512;
    float* BC = (float*)(F.ws + WS_BC) + (size_t)d * MTOK * 8;
    const int lane = F.lane, col = h * 64 + lane;
    const float* mup = F.in[I_MUP] + jl * 1920; const float* mun = F.in[I_MUN] + jl * 1920;
    const float mp_r = mup[col], mn_r = mun[col], mp_k = mup[512 + col], mn_k = mun[512 + col], mp_v = mup[1024 + col], mn_v = mun[1024 + col];
    const float mp_w = mup[1536 + d * 64 + lane], mn_w = mun[1536 + d * 64 + lane], mp_a = mup[1664 + d * 64 + lane], mn_a = mun[1664 + d * 64 + lane];
    const float w0 = F.in[I_BW0][(jl * 2 + d) * 512 + col], a0 = F.in[I_BA0][(jl * 2 + d) * 512 + col];
    const float kk_c = F.in[I_BKK][jl * 512 + col], ka_c = F.in[I_BKA][jl * 512 + col], rk_c = F.in[I_BRK][jl * 512 + col];
    const float* W2 = F.in[I_BW2] + (size_t)(jl * 2 + d) * 64 * 512 + col; const float* A2 = F.in[I_BA2] + (size_t)(jl * 2 + d) * 64 * 512 + col;
    float S[64];
    if (latent) { const f32x4* sp = (const f32x4*)(F.in[I_SB] + ((size_t)(((b * 2 + jl) * 2 + d) * 8 + h) * 64 + lane) * 64);
#pragma unroll
        for (int j4 = 0; j4 < 16; ++j4) { const f32x4 v = sp[j4]; S[4 * j4] = v.x; S[4 * j4 + 1] = v.y; S[4 * j4 + 2] = v.z; S[4 * j4 + 3] = v.w; } }
    else {
#pragma unroll
        for (int j = 0; j < 64; ++j) S[j] = 0.f; }
    for (int blk = 0; blk < T / 8; ++blk) {
        float r_[8], k_[8], v_[8], kk[8];
#pragma unroll
        for (int tt = 0; tt < 8; ++tt) {
            const int s = blk * 8 + tt, t = d ? T - 1 - s : s; const bool hp = t > 0, hn = t < T - 1;
            const bf16* pr = P + (size_t)(m0 + t) * PLD_AB + 768;
            r_[tt] = shift3(pr + col, PLD_AB, hp, hn, mp_r, mn_r); k_[tt] = shift3(pr + 512 + col, PLD_AB, hp, hn, mp_k, mn_k); v_[tt] = shift3(pr + 1024 + col, PLD_AB, hp, hn, mp_v, mn_v);
            const float wd = shift3(pr + 1536 + d * 64 + lane, PLD_AB, hp, hn, mp_w, mn_w), ad = shift3(pr + 1664 + d * 64 + lane, PLD_AB, hp, hn, mp_a, mn_a);
            twl[tt * 64 + lane] = tanhf(wd); adl[tt * 64 + lane] = ad;
            const float kv = k_[tt] * kk_c; const float nrm = sqrtf(wave_sum(kv * kv)); kk[tt] = kv / fmaxf(nrm, 1e-12f);
        }
        asm volatile("s_waitcnt lgkmcnt(0)" ::: "memory");
        float aw[8], aa[8];
#pragma unroll
        for (int tt = 0; tt < 8; ++tt) { aw[tt] = 0.f; aa[tt] = 0.f; }
        for (int l4 = 0; l4 < 16; ++l4) {
            float wv[4], av[4];
#pragma unroll
            for (int q = 0; q < 4; ++q) { wv[q] = W2[(size_t)(4 * l4 + q) * 512]; av[q] = A2[(size_t)(4 * l4 + q) * 512]; }
#pragma unroll
            for (int tt = 0; tt < 8; ++tt) { const f32x4 t4 = *(const LAS f32x4*)(twl + tt * 64 + 4 * l4), a4 = *(const LAS f32x4*)(adl + tt * 64 + 4 * l4);
                aw[tt] += t4.x * wv[0] + t4.y * wv[1] + t4.z * wv[2] + t4.w * wv[3]; aa[tt] += a4.x * av[0] + a4.y * av[1] + a4.z * av[2] + a4.w * av[3]; }
        }
#pragma unroll
        for (int tt = 0; tt < 8; ++tt) {
            const int s = blk * 8 + tt, t = d ? T - 1 - s : s;
            const float x = -(w0 + aw[tt]); const float sp = fmaxf(x, 0.f) + log1pf(__expf(-fabsf(x)));
            const float wlog = -sp - 0.5f; const float dec = __expf(-__expf(wlog));
            const float a = sigmoid_f(a0 + aa[tt]); const float kd = k_[tt] * (1.0f + (a - 1.0f) * ka_c); const float bb = kk[tt] * a;
            const float bon = wave_sum(r_[tt] * kd * rk_c); if (lane == 0) BC[(size_t)(m0 + t) * 8 + h] = bon;
            vec[(0 * 8 + tt) * 64 + lane] = dec; vec[(1 * 8 + tt) * 64 + lane] = kk[tt]; vec[(2 * 8 + tt) * 64 + lane] = bb;
            vec[(3 * 8 + tt) * 64 + lane] = kd; vec[(4 * 8 + tt) * 64 + lane] = r_[tt]; vec[(5 * 8 + tt) * 64 + lane] = v_[tt];
        }
        asm volatile("s_waitcnt lgkmcnt(0)" ::: "memory");
#pragma unroll 1
        for (int tt = 0; tt < 8; ++tt) {
            const int s = blk * 8 + tt, t = d ? T - 1 - s : s;
            const float vi = vec[(5 * 8 + tt) * 64 + lane];
            float sa = 0.f;
#pragma unroll
            for (int j4 = 0; j4 < 16; ++j4) { const f32x4 k4 = *(const LAS f32x4*)(vec + (1 * 8 + tt) * 64 + 4 * j4);
                sa += S[4 * j4] * k4.x + S[4 * j4 + 1] * k4.y + S[4 * j4 + 2] * k4.z + S[4 * j4 + 3] * k4.w; }
            float y = 0.f;
#pragma unroll
            for (int j4 = 0; j4 < 16; ++j4) {
                const f32x4 w4 = *(const LAS f32x4*)(vec + (0 * 8 + tt) * 64 + 4 * j4), b4 = *(const LAS f32x4*)(vec + (2 * 8 + tt) * 64 + 4 * j4);
                const f32x4 k4 = *(const LAS f32x4*)(vec + (3 * 8 + tt) * 64 + 4 * j4), r4 = *(const LAS f32x4*)(vec + (4 * 8 + tt) * 64 + 4 * j4);
#pragma unroll
                for (int q = 0; q < 4; ++q) { float sv = S[4 * j4 + q]; sv = sv * w4[q] - sa * b4[q] + vi * k4[q]; S[4 * j4 + q] = sv; y += sv * r4[q]; }
            }
            Yd[(size_t)(m0 + t) * 512 + col] = (bf16)f2bf(y);
        }
        asm volatile("s_waitcnt lgkmcnt(0)" ::: "memory");
    }
    if (!latent) { f32x4* op = (f32x4*)(F.out + O_BW + ((size_t)(((b * 2 + jl) * 2 + d) * 8 + h) * 64 + lane) * 64);
#pragma unroll
        for (int j4 = 0; j4 < 16; ++j4) op[j4] = (f32x4){S[4 * j4], S[4 * j4 + 1], S[4 * j4 + 2], S[4 * j4 + 3]}; }
}
__device__ __forceinline__ void rwkv_post_phase(Frame& F, int jl) {
    LAS float* sg = (LAS float*)(F.lds + F.wave * 4096);
    const bf16* P = (const bf16*)(F.ws + WS_G); const bf16* Y0 = (const bf16*)(F.ws + WS_Y); const bf16* Y1 = Y0 + (size_t)MTOK * 512;
    const float* BC = (const float*)(F.ws + WS_BC); bf16* O = (bf16*)(F.ws + WS_H);
    const float* g2 = F.in[I_BG2] + (size_t)jl * 128 * 512; const float* mup = F.in[I_MUP] + jl * 1920; const float* mun = F.in[I_MUN] + jl * 1920;
    const int lane = F.lane, c0 = 8 * lane, head = lane >> 3;
    const int gw = F.bid * 8 + F.wave, NGW = F.G * 8;
    float gnw[8], gnb[8], mpv[8], mnv[8];
#pragma unroll
    for (int i = 0; i < 8; ++i) { gnw[i] = F.in[I_GNW][jl * 512 + c0 + i]; gnb[i] = F.in[I_GNB][jl * 512 + c0 + i]; mpv[i] = mup[1024 + c0 + i]; mnv[i] = mun[1024 + c0 + i]; }
    const float mpg0 = mup[1792 + lane], mng0 = mun[1792 + lane], mpg1 = mup[1856 + lane], mng1 = mun[1856 + lane];
    for (int grp = gw; grp < MTOK / 8; grp += NGW) {
#pragma unroll
        for (int tt = 0; tt < 8; ++tt) { const int m = grp * 8 + tt; const int t = m < MPR ? (m & 255) : ((m - MPR) & 4095); const int T = m < MPR ? TP : TL;
            const bf16* pr = P + (size_t)m * PLD_AB + 768 + 1792;
            sg[tt * 128 + lane] = sigmoid_f(shift3(pr + lane, PLD_AB, t > 0, t < T - 1, mpg0, mng0)); sg[tt * 128 + 64 + lane] = sigmoid_f(shift3(pr + 64 + lane, PLD_AB, t > 0, t < T - 1, mpg1, mng1)); }
        asm volatile("s_waitcnt lgkmcnt(0)" ::: "memory");
        float acc[8][8];
#pragma unroll
        for (int tt = 0; tt < 8; ++tt)
#pragma unroll
            for (int i = 0; i < 8; ++i) acc[tt][i] = 0.f;
#pragma unroll 2
        for (int l4 = 0; l4 < 32; ++l4) {
            f32x4 s4[8];
#pragma unroll
            for (int tt = 0; tt < 8; ++tt) s4[tt] = *(const LAS f32x4*)(sg + tt * 128 + 4 * l4);
#pragma unroll
            for (int q = 0; q < 4; ++q) { const f32x4 ga = *(const f32x4*)(g2 + (size_t)(4 * l4 + q) * 512 + c0), gb = *(const f32x4*)(g2 + (size_t)(4 * l4 + q) * 512 + c0 + 4);
#pragma unroll
                for (int tt = 0; tt < 8; ++tt) { const float s = s4[tt][q];
#pragma unroll
                    for (int i = 0; i < 4; ++i) { acc[tt][i] += s * ga[i]; acc[tt][4 + i] += s * gb[i]; } } }
        }
#pragma unroll
        for (int tt = 0; tt < 8; ++tt) { const int m = grp * 8 + tt; const int t = m < MPR ? (m & 255) : ((m - MPR) & 4095); const int T = m < MPR ? TP : TL;
            const bf16x8 ya = *(const bf16x8*)(Y0 + (size_t)m * 512 + c0), yb = *(const bf16x8*)(Y1 + (size_t)m * 512 + c0);
            float y[8]; float sm = 0.f;
#pragma unroll
            for (int i = 0; i < 8; ++i) { y[i] = bf2f((unsigned short)ya[i]) + bf2f((unsigned short)yb[i]); sm += y[i]; }
            sm += __shfl_xor(sm, 1); sm += __shfl_xor(sm, 2); sm += __shfl_xor(sm, 4);
            const float mu = sm * (1.0f / 64.0f); float vs = 0.f;
#pragma unroll
            for (int i = 0; i < 8; ++i) { y[i] -= mu; vs += y[i] * y[i]; }
            vs += __shfl_xor(vs, 1); vs += __shfl_xor(vs, 2); vs += __shfl_xor(vs, 4);
            const float rs = 1.0f / sqrtf(vs * (1.0f / 64.0f) + 64e-5f);
            const bf16* pv = P + (size_t)m * PLD_AB + 768 + 1024 + c0;
            const bf16x8 vc = *(const bf16x8*)pv; bf16x8 vp = vc, vn = vc;
            const bool hp = t > 0, hn = t < T - 1;
            if (hp) vp = *(const bf16x8*)(pv - PLD_AB); if (hn) vn = *(const bf16x8*)(pv + PLD_AB);
            const float bon = BC[(size_t)m * 8 + head] + BC[((size_t)MTOK + m) * 8 + head];
            float o[8];
#pragma unroll
            for (int i = 0; i < 8; ++i) { const float c = bf2f((unsigned short)vc[i]); const float pvv = hp ? bf2f((unsigned short)vp[i]) : 0.f, nvv = hn ? bf2f((unsigned short)vn[i]) : 0.f;
                const float v = c + mpv[i] * (pvv - c) + mnv[i] * (nvv - c);
                o[i] = (y[i] * rs * gnw[i] + gnb[i] + bon * v) * acc[tt][i]; }
            *(u32x4*)(O + (size_t)m * 1024 + 512 + c0) = (u32x4){pk2(o[0], o[1]), pk2(o[2], o[3]), pk2(o[4], o[5]), pk2(o[6], o[7])};
        }
        asm volatile("s_waitcnt lgkmcnt(0)" ::: "memory");
    }
}
constexpr int PT = 72;
constexpr int SLOT = 64 * PT * 2;
constexpr int F32P = 68;
__device__ __forceinline__ LAS bf16* slot(Frame& F, int k) { return (LAS bf16*)(F.lds + k * SLOT); }
__device__ __forceinline__ void mm64(f32x16 (&acc)[2][2], const LAS bf16* A, const LAS bf16* B, int lane) {
    const int r = lane & 31, h = lane >> 5;
#pragma unroll
    for (int ks = 0; ks < 4; ++ks) {
        bf16x8 af[2], bfr[2];
#pragma unroll
        for (int t = 0; t < 2; ++t) { af[t] = *(const LAS bf16x8*)(A + (32 * t + r) * PT + 16 * ks + 8 * h); bfr[t] = *(const LAS bf16x8*)(B + (32 * t + r) * PT + 16 * ks + 8 * h); }
#pragma unroll
        for (int rt = 0; rt < 2; ++rt)
#pragma unroll
            for (int ct = 0; ct < 2; ++ct) acc[rt][ct] = MFMA32(af[rt], bfr[ct], acc[rt][ct]);
    }
}
__device__ __forceinline__ void mm64_gB(f32x16 (&acc)[2][2], const LAS bf16* A, const bf16* Bg, int lane) {
    const int r = lane & 31, h = lane >> 5;
#pragma unroll
    for (int ks = 0; ks < 4; ++ks) {
        bf16x8 af[2], bfr[2];
#pragma unroll
        for (int t = 0; t < 2; ++t) { af[t] = *(const LAS bf16x8*)(A + (32 * t + r) * PT + 16 * ks + 8 * h); bfr[t] = *(const bf16x8*)(Bg + (32 * t + r) * 64 + 16 * ks + 8 * h); }
#pragma unroll
        for (int rt = 0; rt < 2; ++rt)
#pragma unroll
            for (int ct = 0; ct < 2; ++ct) acc[rt][ct] = MFMA32(af[rt], bfr[ct], acc[rt][ct]);
    }
}
__device__ __forceinline__ void zero_acc(f32x16 (&acc)[2][2]) {
#pragma unroll
    for (int a = 0; a < 2; ++a)
#pragma unroll
        for (int b = 0; b < 2; ++b)
#pragma unroll
            for (int i = 0; i < 16; ++i) acc[a][b][i] = 0.f;
}
template <int MASK> __device__ __forceinline__ void store_nat_bf16(const f32x16 (&acc)[2][2], LAS bf16* D, int lane) {
    const int r = lane & 31, h = lane >> 5;
#pragma unroll
    for (int rt = 0; rt < 2; ++rt)
#pragma unroll
        for (int ct = 0; ct < 2; ++ct)
#pragma unroll
            for (int i = 0; i < 16; i += 2) { const int row = 32 * rt + crow(i, h), col = 32 * ct + r; float v0 = acc[rt][ct][i], v1 = acc[rt][ct][i + 1];
                if (MASK && rt < ct) { v0 = 0.f; v1 = 0.f; }
                if (MASK == 1 && rt == ct) { v0 *= (float)((unsigned)(col - row) >> 31); v1 *= (float)((unsigned)(col - row - 1) >> 31); }
                if (MASK == 2 && rt == ct) { v0 *= (float)((unsigned)(col - row - 1) >> 31); v1 *= (float)((unsigned)(col - row - 2) >> 31); }
                const unsigned w = pk2(v0, v1);
                D[row * PT + col] = (bf16)(w & 0xffffu); D[(row + 1) * PT + col] = (bf16)(w >> 16); }
}
template <int MASK> __device__ __forceinline__ void store_nat_f32(const f32x16 (&acc)[2][2], LAS float* D, int lane) {
    const int r = lane & 31, h = lane >> 5;
#pragma unroll
    for (int rt = 0; rt < 2; ++rt)
#pragma unroll
        for (int ct = 0; ct < 2; ++ct)
#pragma unroll
            for (int i = 0; i < 16; ++i) { const int row = 32 * rt + crow(i, h), col = 32 * ct + r; float v = acc[rt][ct][i];
                if (MASK == 1 && rt < ct) v = 0.f;
                if (MASK == 1 && rt == ct) v *= (float)((unsigned)(col - row) >> 31);
                D[row * F32P + col] = v; }
}
__device__ __forceinline__ void store_tr_g(const f32x16 (&acc)[2][2], bf16* D, long pitch, int lane) {
    const int r = lane & 31, h = lane >> 5;
#pragma unroll
    for (int rt = 0; rt < 2; ++rt)
#pragma unroll
        for (int ct = 0; ct < 2; ++ct)
#pragma unroll
            for (int g = 0; g < 4; ++g) { const int row = 32 * rt + 8 * g + 4 * h, col = 32 * ct + r;
                *(u32x2*)(D + (long)col * pitch + row) = (u32x2){pk2(acc[rt][ct][4 * g], acc[rt][ct][4 * g + 1]), pk2(acc[rt][ct][4 * g + 2], acc[rt][ct][4 * g + 3])}; }
}
__device__ __forceinline__ void load8(float (&o)[8], const bf16* p) { const bf16x8 v = *(const bf16x8*)p;
#pragma unroll
    for (int i = 0; i < 8; ++i) o[i] = bf2f((unsigned short)v[i]); }
__device__ __forceinline__ void shift8(float (&o)[8], const bf16* p, bool hp, bool hn, const float* mup, const float* mun) {
    float c[8], a[8], b[8]; load8(c, p);
    if (hp) load8(a, p - PLD_AB); if (hn) load8(b, p + PLD_AB);
#pragma unroll
    for (int i = 0; i < 8; ++i) { const float pv = hp ? a[i] : 0.f, nx = hn ? b[i] : 0.f; o[i] = c[i] + mup[i] * (pv - c[i]) + mun[i] * (nx - c[i]); }
}
__device__ __forceinline__ void solve_col(const LAS float* A, const LAS bf16* rhs, LAS bf16* dst, int lane) {
    float x[64];
    { int z = 0; asm volatile("" : "+v"(z)); A += z; }
#pragma unroll
    for (int t = 0; t < 64; ++t) x[t] = bf2f(rhs[t * PT + lane]);
    asm volatile("s_waitcnt lgkmcnt(0)" ::: "memory");
    x[1] -= A[1 * F32P + 0] * x[0];
#pragma unroll
    for (int t = 2; t < 64; t += 2) {
        float s0 = 0.f, s1 = 0.f, r0 = 0.f, r1 = 0.f;
#pragma unroll
        for (int u4 = 0; u4 < t / 4 + 1; ++u4) { if (4 * u4 < t) { const f32x4 a = *(const LAS f32x4*)(A + t * F32P + 4 * u4), b = *(const LAS f32x4*)(A + (t + 1) * F32P + 4 * u4);
            if (4 * u4 + 0 < t) { s0 += a[0] * x[4 * u4 + 0]; r0 += b[0] * x[4 * u4 + 0]; } if (4 * u4 + 1 < t) { s1 += a[1] * x[4 * u4 + 1]; r1 += b[1] * x[4 * u4 + 1]; }
            if (4 * u4 + 2 < t) { s0 += a[2] * x[4 * u4 + 2]; r0 += b[2] * x[4 * u4 + 2]; } if (4 * u4 + 3 < t) { s1 += a[3] * x[4 * u4 + 3]; r1 += b[3] * x[4 * u4 + 3]; } } }
        x[t] -= s0 + s1;
        x[t + 1] -= (r0 + r1) + A[(t + 1) * F32P + t] * x[t];
        asm volatile("" : "+v"(x[t]), "+v"(x[t + 1]));
    }
    asm volatile("s_waitcnt lgkmcnt(0)" ::: "memory");
#pragma unroll
    for (int q = 0; q < 8; ++q)
        *(LAS u32x4*)(dst + lane * PT + 8 * q) = (u32x4){pk2(x[8 * q], x[8 * q + 1]), pk2(x[8 * q + 2], x[8 * q + 3]), pk2(x[8 * q + 4], x[8 * q + 5]), pk2(x[8 * q + 6], x[8 * q + 7])};
    asm volatile("s_waitcnt lgkmcnt(0)" ::: "memory");
}
constexpr size_t WS_LORA = 7 * MiB;
constexpr size_t WS_R = WS_END;
constexpr size_t WS_END2 = WS_R + 80 * MiB;
__device__ __forceinline__ int r_item(bool latent, int b, int h, int c) { return latent ? ((b * 8 + h) * 64 + c) : (4096 + (b * 8 + h) * 4 + c); }

__device__ __forceinline__ void shift8c(float (&o)[8], const bf16x8& rc, const bf16* p, bool hp, bool hn, const float* mup, const float* mun) {
    float a[8], b[8];
    if (hp) load8(a, p - PLD_AB); if (hn) load8(b, p + PLD_AB);
#pragma unroll
    for (int i = 0; i < 8; ++i) { const float c = bf2f((unsigned short)rc[i]); const float pv = hp ? a[i] : 0.f, nx = hn ? b[i] : 0.f; o[i] = c + mup[i] * (pv - c) + mun[i] * (nx - c); }
}
__device__ __forceinline__ int r1_map(int it0, int bid, int G) {
    if (G != 256) return it0;
    const int k = it0 >> 8, xcd = bid & 7, slot = bid >> 3, sck = k * 32 + xcd * 4 + (slot >> 3), hq = slot & 7;
    return sck < 512 ? (((sck >> 6) << 9) | (hq << 6) | (sck & 63)) : 4096 + ((((sck - 512) >> 2) << 5) | (hq << 2) | ((sck - 512) & 3));
}
__device__ __forceinline__ void bar_all() { asm volatile("s_waitcnt vmcnt(0) lgkmcnt(0)" ::: "memory"); __builtin_amdgcn_s_barrier(); asm volatile("" ::: "memory"); }
__device__ __forceinline__ void rwkv_r1(Frame& F, int jl, int d) {
    LAS bf16* S0 = slot(F, 0); LAS bf16* S1 = slot(F, 1); LAS bf16* S2 = slot(F, 2); LAS bf16* S3 = slot(F, 3); LAS bf16* S4 = slot(F, 4);
    LAS bf16* S5 = slot(F, 5); LAS bf16* S6 = slot(F, 6); LAS bf16* S7 = slot(F, 7); LAS bf16* S8 = slot(F, 8);
    LAS bf16* S9 = slot(F, 9); LAS bf16* S10 = slot(F, 10); LAS bf16* S11 = slot(F, 11);
    LAS float* F32 = (LAS float*)(F.lds + 12 * SLOT); LAS float* PCv = F32 + 64 * F32P; LAS float* KN = PCv + 64; LAS float* BN = KN + 512;
    const bf16* P = (const bf16*)(F.ws + WS_G);
    bf16* Yd = (bf16*)(F.ws + WS_Y) + (size_t)d * MTOK * 512; bf16* Ob = (bf16*)(F.ws + WS_H);
    float* BC = (float*)(F.ws + WS_BC) + (size_t)d * MTOK * 8;
    const float* mup_u = F.in[I_MUP] + jl * 1920; const float* mun_u = F.in[I_MUN] + jl * 1920;
    const int w = F.wave;
    bf16x8 rawc[5];
#define R1_LOADRAW(IT, LANE) do { int b_, h_, c_, T_, m0_; if ((IT) < 4096) { b_ = (IT) >> 9; h_ = ((IT) >> 6) & 7; c_ = (IT) & 63; T_ = TL; m0_ = MPR + b_ * TL; } \
        else { const int p_ = (IT) - 4096; b_ = p_ >> 5; h_ = (p_ >> 2) & 7; c_ = p_ & 3; T_ = TP; m0_ = b_ * TP; } \
        const int tok_ = d ? T_ - 1 - (64 * c_ + (LANE)) : 64 * c_ + (LANE); const bf16* pr_ = P + (size_t)(m0_ + tok_) * PLD_AB + 768 + 8 * w; const int hc_ = h_ * 64; \
        rawc[0] = *(const bf16x8*)(pr_ + hc_); rawc[1] = *(const bf16x8*)(pr_ + 1024 + hc_); rawc[2] = *(const bf16x8*)(pr_ + 1536 + d * 64); rawc[3] = *(const bf16x8*)(pr_ + 1664 + d * 64); rawc[4] = *(const bf16x8*)(pr_ + 512 + hc_); } while (0)
    if (F.bid < 5120) R1_LOADRAW(r1_map(F.bid, F.bid, F.G), F.lane);
    for (int it0 = F.bid; it0 < 5120; it0 += F.G) {
        const int it = r1_map(it0, F.bid, F.G);
        int lane = F.lane; asm volatile("" : "+v"(lane));
        int zv = 0; asm volatile("" : "+v"(zv));
        const float* mup = mup_u + zv; const float* mun = mun_u + zv;
        const float* pKK = F.in[I_BKK] + jl * 512 + zv; const float* pKA = F.in[I_BKA] + jl * 512 + zv; const float* pRK = F.in[I_BRK] + jl * 512 + zv; const float* pA0 = F.in[I_BA0] + (jl * 2 + d) * 512 + zv;
        int b, h, c, T, m0; const bool latent = it < 4096;
        if (latent) { b = it >> 9; h = (it >> 6) & 7; c = it & 63; T = TL; m0 = MPR + b * TL; }
        else { const int p = it - 4096; b = p >> 5; h = (p >> 2) & 7; c = p & 3; T = TP; m0 = b * TP; }
        const int tok = d ? T - 1 - (64 * c + lane) : 64 * c + lane;
        const bool hp = tok > 0, hn = tok < T - 1;
        const bf16* prow = P + (size_t)(m0 + tok) * PLD_AB + 768;
        const int hc = h * 64, q = w;
        const int r = lane & 31, hh = lane >> 5;
        float k8[8], r8[8], v8[8];
        shift8c(r8, rawc[0], prow + hc + 8 * q, hp, hn, mup + hc + 8 * q, mun + hc + 8 * q);
        shift8c(v8, rawc[1], prow + 1024 + hc + 8 * q, hp, hn, mup + 1024 + hc + 8 * q, mun + 1024 + hc + 8 * q);
        { float x[8];
          shift8c(x, rawc[2], prow + 1536 + d * 64 + 8 * q, hp, hn, mup + 1536 + d * 64 + 8 * q, mun + 1536 + d * 64 + 8 * q);
          *(LAS u32x4*)(S0 + lane * PT + 8 * q) = (u32x4){pk2(tanh_f(x[0]), tanh_f(x[1])), pk2(tanh_f(x[2]), tanh_f(x[3])), pk2(tanh_f(x[4]), tanh_f(x[5])), pk2(tanh_f(x[6]), tanh_f(x[7]))};
          shift8c(x, rawc[3], prow + 1664 + d * 64 + 8 * q, hp, hn, mup + 1664 + d * 64 + 8 * q, mun + 1664 + d * 64 + 8 * q);
          *(LAS u32x4*)(S1 + lane * PT + 8 * q) = (u32x4){pk2(x[0], x[1]), pk2(x[2], x[3]), pk2(x[4], x[5]), pk2(x[6], x[7])};
          shift8c(k8, rawc[4], prow + 512 + hc + 8 * q, hp, hn, mup + 512 + hc + 8 * q, mun + 512 + hc + 8 * q);
          float ss = 0.f;
#pragma unroll
          for (int i = 0; i < 8; ++i) { const float kv = k8[i] * pKK[hc + 8 * q + i]; ss += kv * kv; }
          KN[q * 64 + lane] = ss; }
        bar_all();
        if (w == 0) { f32x16 acc[2][2]; zero_acc(acc); mm64_gB(acc, S0, (const bf16*)(F.ws + WS_LORA) + ((size_t)(jl * 2 + d) * 512 + hc) * 64, lane); store_nat_f32<0>(acc, F32, lane); }
        else if (w == 1) { f32x16 acc[2][2]; zero_acc(acc); mm64_gB(acc, S1, (const bf16*)(F.ws + WS_LORA) + ((size_t)(4 + jl * 2 + d) * 512 + hc) * 64, lane); store_nat_bf16<0>(acc, S2, lane); }
        bar_all();
        { const float w0 = F.in[I_BW0][(jl * 2 + d) * 512 + hc + lane];
#pragma unroll
          for (int tt = 0; tt < 8; ++tt) { const int t = 8 * w + tt; const float x = -(w0 + F32[t * F32P + lane]); const float sp = fmaxf(x, 0.f) + 0.6931471805599453f * __builtin_amdgcn_logf(1.0f + __builtin_amdgcn_exp2f(-1.4426950408889634f * fabsf(x)));
              F32[t * F32P + lane] = -__expf(-sp - 0.5f); } }
        bar_all();
        if (w == 0) { float cum = 0.f;
#pragma unroll 16
          for (int t = 0; t < 64; ++t) { cum += F32[t * F32P + lane]; F32[t * F32P + lane] = cum; }
          PCv[lane] = cum; }
        bar_all();
        { float ss = 0.f;
#pragma unroll
          for (int u = 0; u < 8; ++u) ss += KN[u * 64 + lane];
          const float knorm = 1.0f / fmaxf(sqrtf(ss), 1e-12f);
          float al[8], lp[8], lpm[8];
          { const bf16x8 av = *(const LAS bf16x8*)(S2 + lane * PT + 8 * q);
#pragma unroll
            for (int i = 0; i < 8; ++i) al[i] = bf2f((unsigned short)av[i]); }
          { const f32x4 a = *(const LAS f32x4*)(F32 + lane * F32P + 8 * q), b4 = *(const LAS f32x4*)(F32 + lane * F32P + 8 * q + 4);
            lp[0] = a[0]; lp[1] = a[1]; lp[2] = a[2]; lp[3] = a[3]; lp[4] = b4[0]; lp[5] = b4[1]; lp[6] = b4[2]; lp[7] = b4[3];
            if (lane > 0) { const f32x4 c4 = *(const LAS f32x4*)(F32 + (lane - 1) * F32P + 8 * q), d4 = *(const LAS f32x4*)(F32 + (lane - 1) * F32P + 8 * q + 4);
                lpm[0] = c4[0]; lpm[1] = c4[1]; lpm[2] = c4[2]; lpm[3] = c4[3]; lpm[4] = d4[0]; lpm[5] = d4[1]; lpm[6] = d4[2]; lpm[7] = d4[3]; }
            else {
#pragma unroll
                for (int i = 0; i < 8; ++i) lpm[i] = 0.f; } }
          float kkh[8], bt[8], kt[8], rh[8]; float bonus = 0.f;
#pragma unroll
          for (int i = 0; i < 8; ++i) { const int j = hc + 8 * q + i;
              const float a = sigmoid_f(pA0[j] + al[i]);
              const float kk = k8[i] * pKK[j] * knorm;
              const float kd = k8[i] * (1.0f + (a - 1.0f) * pKA[j]);
              const float bb = kk * a;
              bonus += r8[i] * kd * pRK[j];
              const float ip = __expf(-lp[i]), pcp = __expf(PCv[8 * q + i] - lp[i]);
              kkh[i] = kk * __expf(lpm[i]); bt[i] = bb * ip; kt[i] = kd * ip; rh[i] = r8[i] * __expf(lp[i]);
              S5[(8 * q + i) * PT + lane] = (bf16)f2bf(bb * pcp); S6[(8 * q + i) * PT + lane] = (bf16)f2bf(kd * pcp); S7[(8 * q + i) * PT + lane] = (bf16)f2bf(v8[i]); }
          *(LAS u32x4*)(S0 + lane * PT + 8 * q) = (u32x4){pk2(kkh[0], kkh[1]), pk2(kkh[2], kkh[3]), pk2(kkh[4], kkh[5]), pk2(kkh[6], kkh[7])};
          *(LAS u32x4*)(S1 + lane * PT + 8 * q) = (u32x4){pk2(bt[0], bt[1]), pk2(bt[2], bt[3]), pk2(bt[4], bt[5]), pk2(bt[6], bt[7])};
          *(LAS u32x4*)(S3 + lane * PT + 8 * q) = (u32x4){pk2(kt[0], kt[1]), pk2(kt[2], kt[3]), pk2(kt[4], kt[5]), pk2(kt[6], kt[7])};
          *(LAS u32x4*)(S4 + lane * PT + 8 * q) = (u32x4){pk2(rh[0], rh[1]), pk2(rh[2], rh[3]), pk2(rh[4], rh[5]), pk2(rh[6], rh[7])};
          BN[q * 64 + lane] = bonus; }
        bar_all();
        if (w == 0) { f32x16 acc[2][2]; zero_acc(acc); mm64(acc, S0, S1, lane); store_nat_f32<1>(acc, F32, lane); }
        else if (w == 1) { f32x16 acc[2][2]; zero_acc(acc); mm64(acc, S0, S3, lane); store_nat_bf16<1>(acc, S2, lane);
            asm volatile("s_waitcnt lgkmcnt(0)" ::: "memory");
            zero_acc(acc); mm64(acc, S2, S7, lane); store_nat_bf16<0>(acc, S8, lane); }
        else if (w == 2) { f32x16 acc[2][2]; zero_acc(acc); mm64(acc, S4, S1, lane); store_nat_bf16<2>(acc, S9, lane); }
        else if (w == 3) { f32x16 acc[2][2]; zero_acc(acc); mm64(acc, S4, S3, lane); store_nat_bf16<2>(acc, S10, lane); }
        else if (w == 4) { float bs = 0.f;
#pragma unroll
            for (int u = 0; u < 8; ++u) bs += BN[u * 64 + lane];
            BC[(size_t)(m0 + tok) * 8 + h] = bs; }
        bar_all();
        if (w == 0) solve_col(F32, S0, S0, lane);
        else if (w == 1) solve_col(F32, S8, S11, lane);
        bar_all();
        if (it0 + F.G < 5120) R1_LOADRAW(r1_map(it0 + F.G, F.bid, F.G), lane);
        bf16* RM = (bf16*)(F.ws + WS_R) + (size_t)it * 8192;
        if (w == 0) { f32x16 acc[2][2]; zero_acc(acc); mm64(acc, S0, S5, lane);
          float pcc[2]; pcc[0] = __expf(PCv[r]); pcc[1] = __expf(PCv[32 + r]);
#pragma unroll
          for (int rt = 0; rt < 2; ++rt)
#pragma unroll
              for (int ct = 0; ct < 2; ++ct)
#pragma unroll
                  for (int i = 0; i < 16; ++i) { const int row = 32 * rt + crow(i, hh), col = 32 * ct + r; acc[rt][ct][i] = (row == col ? pcc[ct] : 0.f) - acc[rt][ct][i]; }
#pragma unroll
          for (int jq = 0; jq < 2; ++jq)
#pragma unroll
              for (int jt = 0; jt < 2; ++jt)
#pragma unroll
                  for (int s2 = 0; s2 < 2; ++s2) *(bf16x8*)(RM + ((jq * 2 + jt) * 2 + s2) * 512 + lane * 8) = pack8(acc[jt][jq], s2); }
        else if (w == 1) { f32x16 a1[2][2]; zero_acc(a1); mm64(a1, S5, S11, lane);
#pragma unroll
          for (int rt = 0; rt < 2; ++rt)
#pragma unroll
              for (int ct = 0; ct < 2; ++ct) a1[rt][ct] = -a1[rt][ct];
          mm64(a1, S6, S7, lane);
#pragma unroll
          for (int jq = 0; jq < 2; ++jq)
#pragma unroll
              for (int it2 = 0; it2 < 2; ++it2)
#pragma unroll
                  for (int s2 = 0; s2 < 2; ++s2) *(bf16x8*)(RM + 4096 + ((jq * 2 + it2) * 2 + s2) * 512 + lane * 8) = pack8(a1[jq][it2], s2); }
        else if (w == 2) { f32x16 a1[2][2]; zero_acc(a1); mm64(a1, S0, S9, lane);
#pragma unroll
          for (int jt = 0; jt < 2; ++jt)
#pragma unroll
              for (int ct = 0; ct < 2; ++ct) { const int t = 32 * ct + r; const int tk = d ? T - 1 - (64 * c + t) : 64 * c + t;
#pragma unroll
                  for (int s2 = 0; s2 < 2; ++s2) { const int j0 = 32 * jt + 16 * s2 + 4 * hh;
                      const s16x4 ra = *(const LAS s16x4*)(S4 + t * PT + j0), rb = *(const LAS s16x4*)(S4 + t * PT + j0 + 8);
                      u32x4 wv; wv.x = pk2(bf2f((unsigned short)ra[0]) - a1[jt][ct][8 * s2], bf2f((unsigned short)ra[1]) - a1[jt][ct][8 * s2 + 1]); wv.y = pk2(bf2f((unsigned short)ra[2]) - a1[jt][ct][8 * s2 + 2], bf2f((unsigned short)ra[3]) - a1[jt][ct][8 * s2 + 3]);
                      wv.z = pk2(bf2f((unsigned short)rb[0]) - a1[jt][ct][8 * s2 + 4], bf2f((unsigned short)rb[1]) - a1[jt][ct][8 * s2 + 5]); wv.w = pk2(bf2f((unsigned short)rb[2]) - a1[jt][ct][8 * s2 + 6], bf2f((unsigned short)rb[3]) - a1[jt][ct][8 * s2 + 7]);
                      *(u32x4*)(Ob + (size_t)(m0 + tk) * 1024 + 512 + hc + ((jt * 2 + s2) * 2 + hh) * 8) = wv; } } }
        else if (w == 3) { f32x16 a1[2][2]; zero_acc(a1); mm64(a1, S11, S9, lane);
#pragma unroll
          for (int rt = 0; rt < 2; ++rt)
#pragma unroll
              for (int ct = 0; ct < 2; ++ct) a1[rt][ct] = -a1[rt][ct];
          mm64(a1, S7, S10, lane);
#pragma unroll
          for (int rt = 0; rt < 2; ++rt)
#pragma unroll
              for (int ct = 0; ct < 2; ++ct)
#pragma unroll
                  for (int g = 0; g < 4; ++g) { const int i0 = 32 * rt + 8 * g + 4 * hh, t = 32 * ct + r; const int tk = d ? T - 1 - (64 * c + t) : 64 * c + t;
                      *(u32x2*)(Yd + (size_t)(m0 + tk) * 512 + hc + i0) = (u32x2){pk2(a1[rt][ct][4 * g], a1[rt][ct][4 * g + 1]), pk2(a1[rt][ct][4 * g + 2], a1[rt][ct][4 * g + 3])}; } }
        bar_all();
    }
#undef R1_LOADRAW
}

__device__ __forceinline__ bf16x8 ld_perm(const bf16* p) {
    const s16x4 lo = *(const s16x4*)p, hi = *(const s16x4*)(p + 8); return __builtin_shufflevector(lo, hi, 0, 1, 2, 3, 4, 5, 6, 7);
}
__device__ __forceinline__ void rwkv_r2a(Frame& F, int jl, int d) {
    const int sc = F.wave * F.G + F.bid;
    if (F.wave >= 2 || sc >= 320) return;
    const int lane = F.lane, r = lane & 31, hh = lane >> 5;
    int b, h, T; const bool latent = sc < 64;
    if (latent) { b = sc >> 3; h = sc & 7; T = TL; } else { const int p = sc - 64; b = p >> 3; h = p & 7; T = TP; }
    f32x16 S[2][2];
    if (latent) { const float* sp = F.in[I_SB] + (size_t)(((b * 2 + jl) * 2 + d) * 8 + h) * 4096;
#pragma unroll
        for (int jt = 0; jt < 2; ++jt)
#pragma unroll
            for (int it = 0; it < 2; ++it)
#pragma unroll
                for (int g = 0; g < 4; ++g) { const f32x4 v = *(const f32x4*)(sp + (32 * it + r) * 64 + 32 * jt + 8 * g + 4 * hh);
                    S[jt][it][4 * g] = v[0]; S[jt][it][4 * g + 1] = v[1]; S[jt][it][4 * g + 2] = v[2]; S[jt][it][4 * g + 3] = v[3]; } }
    else zero_acc(S);
    const int NC = T / 64;
    LAS unsigned char* ring = F.lds + F.wave * 65536;
    constexpr int DEPTH = 3;
#define R2_DMA(CI) do { const bf16* RM_ = (const bf16*)(F.ws + WS_R) + (size_t)r_item(latent, b, h, (CI)) * 8192 + lane * 8; \
        LAS unsigned char* dst_ = ring + ((CI) & 3) * 16384; \
        _Pragma("unroll") for (int f_ = 0; f_ < 16; ++f_) __builtin_amdgcn_global_load_lds((const unsigned*)(RM_ + f_ * 512), (LAS unsigned*)(dst_ + f_ * 1024), 16, 0, 0); } while (0)
    for (int c0 = 0; c0 < DEPTH && c0 < NC; ++c0) R2_DMA(c0);
    for (int c = 0; c < NC; ++c) {
        bf16* RMc = (bf16*)(F.ws + WS_R) + (size_t)r_item(latent, b, h, c) * 8192 + lane * 8;
        const int rem = NC - 1 - c;
        const int allow = 16 * (rem < 2 ? rem : 2) + 8 * (c < 2 ? c : 2);
        if (allow >= 48) asm volatile("s_waitcnt vmcnt(48)" ::: "memory"); else if (allow >= 40) asm volatile("s_waitcnt vmcnt(40)" ::: "memory");
        else if (allow >= 32) asm volatile("s_waitcnt vmcnt(32)" ::: "memory"); else if (allow >= 24) asm volatile("s_waitcnt vmcnt(24)" ::: "memory");
        else if (allow >= 16) asm volatile("s_waitcnt vmcnt(16)" ::: "memory"); else if (allow >= 8) asm volatile("s_waitcnt vmcnt(8)" ::: "memory");
        else asm volatile("s_waitcnt vmcnt(0)" ::: "memory");
        const LAS bf16x8* fr = (const LAS bf16x8*)(ring + (c & 3) * 16384) + lane;
        bf16x8 Mc[2][2][2], Nc[2][2][2];
#pragma unroll
        for (int a_ = 0; a_ < 2; ++a_)
#pragma unroll
            for (int b_ = 0; b_ < 2; ++b_)
#pragma unroll
                for (int s2 = 0; s2 < 2; ++s2) { Mc[a_][b_][s2] = fr[((a_ * 2 + b_) * 2 + s2) * 64]; Nc[a_][b_][s2] = fr[(8 + (a_ * 2 + b_) * 2 + s2) * 64]; }
        asm volatile("s_waitcnt lgkmcnt(0)" ::: "memory");
        bf16x8 Sb[2][2][2];
#pragma unroll
        for (int jt = 0; jt < 2; ++jt)
#pragma unroll
            for (int s2 = 0; s2 < 2; ++s2)
#pragma unroll
                for (int it = 0; it < 2; ++it) { Sb[jt][s2][it] = pack8(S[jt][it], s2); *(bf16x8*)(RMc + ((jt * 2 + s2) * 2 + it) * 512) = Sb[jt][s2][it]; }
        if (c + DEPTH < NC) R2_DMA(c + DEPTH);
        f32x16 Sn[2][2];
#pragma unroll
        for (int jq = 0; jq < 2; ++jq)
#pragma unroll
            for (int it = 0; it < 2; ++it)
#pragma unroll
                for (int s2 = 0; s2 < 2; ++s2)
#pragma unroll
                    for (int jj = 0; jj < 8; ++jj) Sn[jq][it][8 * s2 + jj] = bf2f((unsigned short)Nc[jq][it][s2][jj]);
#pragma unroll
        for (int jq = 0; jq < 2; ++jq)
#pragma unroll
            for (int jt = 0; jt < 2; ++jt)
#pragma unroll
                for (int s2 = 0; s2 < 2; ++s2)
#pragma unroll
                    for (int it = 0; it < 2; ++it) Sn[jq][it] = MFMA32(Mc[jq][jt][s2], Sb[jt][s2][it], Sn[jq][it]);
#pragma unroll
        for (int jq = 0; jq < 2; ++jq)
#pragma unroll
            for (int it = 0; it < 2; ++it) S[jq][it] = Sn[jq][it];
    }
    asm volatile("s_waitcnt vmcnt(0)" ::: "memory");
#define R2_LOAD(x)
#undef R2_LOAD
    if (!latent) { float* op = F.out + O_BW + (size_t)(((b * 2 + jl) * 2 + d) * 8 + h) * 4096;
#pragma unroll
        for (int jt = 0; jt < 2; ++jt)
#pragma unroll
            for (int it = 0; it < 2; ++it)
#pragma unroll
                for (int g = 0; g < 4; ++g) *(f32x4*)(op + (32 * it + r) * 64 + 32 * jt + 8 * g + 4 * hh) = (f32x4){S[jt][it][4 * g], S[jt][it][4 * g + 1], S[jt][it][4 * g + 2], S[jt][it][4 * g + 3]}; }
}
__device__ __forceinline__ void rwkv_r2b(Frame& F, int jl, int d) {
    const int lane = F.lane, r = lane & 31, hh = lane >> 5;
    bf16* Yd = (bf16*)(F.ws + WS_Y) + (size_t)d * MTOK * 512; const bf16* Ob = (const bf16*)(F.ws + WS_H);
    for (int it = F.bid * 8 + F.wave; it < 5120; it += F.G * 8) {
        int b, h, c, T, m0; const bool latent = it < 4096;
        if (latent) { b = it >> 9; h = (it >> 6) & 7; c = it & 63; T = TL; m0 = MPR + b * TL; }
        else { const int p = it - 4096; b = p >> 5; h = (p >> 2) & 7; c = p & 3; T = TP; m0 = b * TP; }
        const int hc = h * 64;
        const bf16* RM = (const bf16*)(F.ws + WS_R) + (size_t)it * 8192 + lane * 8;
        bf16x8 Sb[2][2][2];
#pragma unroll
        for (int jt = 0; jt < 2; ++jt)
#pragma unroll
            for (int s2 = 0; s2 < 2; ++s2)
#pragma unroll
                for (int i2 = 0; i2 < 2; ++i2) Sb[jt][s2][i2] = *(const bf16x8*)(RM + ((jt * 2 + s2) * 2 + i2) * 512);
#pragma unroll
        for (int tt = 0; tt < 2; ++tt) {
            const int t = 32 * tt + r; const int tk = d ? T - 1 - (64 * c + t) : 64 * c + t;
            const bf16* qp = Ob + (size_t)(m0 + tk) * 1024 + 512 + hc + 8 * hh; bf16* yp = Yd + (size_t)(m0 + tk) * 512 + hc + 4 * hh;
            f32x16 y[2];
#pragma unroll
            for (int i2 = 0; i2 < 2; ++i2)
#pragma unroll
                for (int g = 0; g < 4; ++g) { const s16x4 z = *(const s16x4*)(yp + 32 * i2 + 8 * g);
                    y[i2][4 * g] = bf2f((unsigned short)z[0]); y[i2][4 * g + 1] = bf2f((unsigned short)z[1]); y[i2][4 * g + 2] = bf2f((unsigned short)z[2]); y[i2][4 * g + 3] = bf2f((unsigned short)z[3]); }
#pragma unroll
            for (int jt = 0; jt < 2; ++jt)
#pragma unroll
                for (int s2 = 0; s2 < 2; ++s2) { const bf16x8 qf = *(const bf16x8*)(qp + (jt * 2 + s2) * 16);
#pragma unroll
                    for (int i2 = 0; i2 < 2; ++i2) y[i2] = MFMA32(Sb[jt][s2][i2], qf, y[i2]); }
#pragma unroll
            for (int i2 = 0; i2 < 2; ++i2)
#pragma unroll
                for (int g = 0; g < 4; ++g) *(u32x2*)(yp + 32 * i2 + 8 * g) = (u32x2){pk2(y[i2][4 * g], y[i2][4 * g + 1]), pk2(y[i2][4 * g + 2], y[i2][4 * g + 3])};
        }
    }
}
#ifndef REP_MASK
#define REP_MASK 0
#endif
#ifndef EN_MASK
#define EN_MASK 0xffff
#endif
#define EN(k) (((EN_MASK) >> (k)) & 1)
constexpr int NPHASE = 54;
constexpr int LDS_BYTES = 147456;
constexpr int LDS_BARST = 147200;
#define XB_TMO      128
#define XB_XCNT(j)  (256  + 64 * (j))
#define XB_XSUB(j)  (1280 + 64 * (j))
#define XB_XGEN(j)  (2304 + 64 * (j))
#define XB_TOP      3328
#define XB_TOPGEN   3392
#define XCD_BAR_WORDS 3456
#define XB_SPIN_CAP (1u << 18)

__device__ __forceinline__ unsigned xb_ld(unsigned* p)              { return __hip_atomic_load(p, __ATOMIC_RELAXED, __HIP_MEMORY_SCOPE_AGENT); }
__device__ __forceinline__ unsigned xb_add(unsigned* p, unsigned v) { return __hip_atomic_fetch_add(p, v, __ATOMIC_RELAXED, __HIP_MEMORY_SCOPE_AGENT); }
__device__ __forceinline__ unsigned xb_xcc_id() { return (unsigned)__builtin_amdgcn_s_getreg((3 << 11) | 20) & 0xFu; }
#define XB_SPIN(cond, bar) do { unsigned _sp = 0; while (cond) { __builtin_amdgcn_s_sleep(1); \
    if ((++_sp & 255u) == 0u) { if (xb_ld(&(bar)[XB_TMO])) break; if (_sp > XB_SPIN_CAP) { atomicAdd(&(bar)[XB_TMO], 1u); break; } } } } while (0)

struct XcdBarrier {
    unsigned* bar; unsigned x;
    volatile LAS unsigned* st;
};

__device__ __forceinline__ XcdBarrier xcd_barrier_post(unsigned* bar, volatile LAS unsigned* st) {
    XcdBarrier b; b.bar = bar; b.x = xb_xcc_id(); b.st = st;
    if (threadIdx.x == 0) (void)xb_add(&bar[XB_XCNT(b.x)], 1u);
    return b;
}
__device__ __forceinline__ void xcd_barrier_complete(unsigned* bar, unsigned x, unsigned& nloc, unsigned& nx) {
    const unsigned G = gridDim.x * gridDim.y * gridDim.z;
    unsigned sum, cnt, mine, sp = 0u;
    for (;;) {
        sum = 0u; cnt = 0u; mine = 0u;
#pragma unroll
        for (unsigned j = 0; j < 16; ++j) { const unsigned c = xb_ld(&bar[XB_XCNT(j)]); sum += c; cnt += (c > 0u) ? 1u : 0u; mine = (j == x) ? c : mine; }
        if (sum == G) break;
        __builtin_amdgcn_s_sleep(1);
        if ((++sp & 255u) == 0u) { if (xb_ld(&bar[XB_TMO])) break; if (sp > XB_SPIN_CAP) { atomicAdd(&bar[XB_TMO], 1u); break; } }
    }
    nloc = mine > 0u ? mine : 1u; nx = cnt > 0u ? cnt : 1u;
}

__device__ __forceinline__ void xcd_barrier(const XcdBarrier& b) {
    asm volatile("s_waitcnt vmcnt(0)" ::: "memory");
    __syncthreads();
    if (threadIdx.x == 0) {
        unsigned* bar = b.bar;
        __builtin_amdgcn_s_waitcnt(0);
        unsigned nloc = b.st[0], nx = b.st[1];
        if (nloc == 0u) { xcd_barrier_complete(bar, b.x, nloc, nx); b.st[0] = nloc; b.st[1] = nx; }
        const unsigned old = xb_add(&bar[XB_XSUB(b.x)], 1u);
        const unsigned gen = old / nloc;
        if (old + 1u == (gen + 1u) * nloc) {
            __builtin_amdgcn_fence(__ATOMIC_RELEASE, "agent");
            asm volatile("s_waitcnt vmcnt(0)" ::: "memory");
            const unsigned og = xb_add(&bar[XB_TOP], 1u);
            const unsigned tg = og / nx;
            if (og + 1u == (tg + 1u) * nx) xb_add(&bar[XB_TOPGEN], 1u);
            else XB_SPIN(xb_ld(&bar[XB_TOPGEN]) == tg, bar);
            __builtin_amdgcn_fence(__ATOMIC_ACQUIRE, "agent");
            xb_add(&bar[XB_XGEN(b.x)], 1u);
            asm volatile("s_waitcnt vmcnt(0)" ::: "memory");
        } else {
            XB_SPIN(xb_ld(&bar[XB_XGEN(b.x)]) == gen, bar);
            __builtin_amdgcn_fence(__ATOMIC_ACQUIRE, "agent");
            asm volatile("s_waitcnt vmcnt(0)" ::: "memory");
        }
    }
    __syncthreads();
}

__device__ __forceinline__ unsigned launder_s(unsigned x) { unsigned y; asm volatile("s_mov_b32 %0, %1" : "=s"(y) : "s"(x)); return y; }
__device__ __forceinline__ void* launder_ptr(const void* p) {
    const unsigned lo = launder_s((unsigned)(uintptr_t)p), hi = launder_s((unsigned)((uintptr_t)p >> 32));
    return (void*)(((uintptr_t)hi << 32) | (uintptr_t)lo);
}
__global__ void __launch_bounds__(512, 2) fwd_kernel(Args args) {
    extern __shared__ __attribute__((aligned(16))) unsigned char lds_raw[];
    Frame F;
    F.lds = (LAS unsigned char*)lds_raw;
    F.in = args.in; F.out = args.out; F.ws = args.ws;
    unsigned char* ws = args.ws;
    if (threadIdx.x == 0) { ((volatile LAS unsigned*)(F.lds + LDS_BARST))[0] = 0u; ((volatile LAS unsigned*)(F.lds + LDS_BARST))[1] = 0u; }
    __syncthreads();
    XcdBarrier xbar = xcd_barrier_post((unsigned*)args.ws, (volatile LAS unsigned*)(F.lds + LDS_BARST));
    bool first = true; int nseam = 0;
    for (int vp = 2 * args.ph_lo; vp < 2 * args.ph_hi; ++vp) {
        const int ph = vp >> 1, rep = vp & 1;
        { int t_ = threadIdx.x; asm volatile("" : "+v"(t_)); F.tid = t_; F.lane = t_ & 63; F.wave = __builtin_amdgcn_readfirstlane(t_ >> 6);
          F.bid = (int)launder_s(blockIdx.x); F.G = (int)launder_s(gridDim.x); }
        ws = (unsigned char*)launder_ptr(args.ws); F.ws = ws; F.out = (float*)launder_ptr(args.out); F.in = args.in;
        const float* modp = (const float*)(ws + WS_MOD);
        int kind, l = 0, s = 0;
        if (ph == 0) kind = 0; else if (ph == NPHASE - 1) kind = 11;
        int dsel = 0;
        if (ph != 0 && ph != NPHASE - 1) { int q = ph - 1; if (q < 16) { l = 0; } else if (q < 26) { l = 1; q -= 16; } else if (q < 42) { l = 2; q -= 26; } else { l = 3; q -= 42; }
            if (!(l & 1)) { kind = (int)((0x32176fedfc541321ull >> (4 * q)) & 15ull); s = (int)((0x1120000000001000ull >> (4 * q)) & 15ull); dsel = q >= 8; }
            else { kind = (int)((0x321a981321ull >> (4 * q)) & 15ull); s = (int)((0x1120001000ull >> (4 * q)) & 15ull); } }
        const int jl = l >> 1;
        if (rep && !((REP_MASK >> kind) & 1)) continue;
        const float rscale = rep ? 0.f : 1.f;
        if (!first) { if (nseam == 0) { __threadfence(); cg::this_grid().sync(); } else xcd_barrier(xbar); ++nseam; }
        first = false;
        if (kind == 0) { if (EN(0)) prologue(F); }
        else if (kind == 1) { if (EN(1)) norm_phase(F, l, s); }
        else if (kind == 2) { if (EN(2)) {
            pg8::Gemm g{(const pg8::bf16_t*)(ws + WS_H), (const pg8::bf16_t*)(ws + WS_W13) + (size_t)(l * 2 + s) * 5632 * 1024, MTOK, 5632, 1024, 1024};
            pg8::StaticOrder S; S.init(MTOK, 5632, F.G, F.bid); pg8::EpiSwiGLU E{(pg8::bf16_t*)(ws + WS_G)};
            pg8::gemm_phase<pg8::EpiSwiGLU, pg8::StaticOrder, true, true>(F.lds, g, S, E, F.tid); }
        } else if (kind == 3) { if (EN(3)) {
            pg8::Gemm g{(const pg8::bf16_t*)(ws + WS_G), (const pg8::bf16_t*)(ws + WS_W2) + (size_t)(l * 2 + s) * 1024 * 2816, MTOK, 1024, 2816, 2816};
            pg8::StaticOrder S; S.init(MTOK, 1024, F.G, F.bid); pg8::EpiResid<false> E{F.out, modp + (size_t)l * 9 * 9216 + (s == 0 ? 2 : 8) * 1024, 0.5f * rscale};
            pg8::gemm_phase<pg8::EpiResid<false>, pg8::StaticOrder, true, true>(F.lds, g, S, E, F.tid); }
        } else if (kind == 4) { if (EN(4)) {
            pg8::Gemm g{(const pg8::bf16_t*)(ws + WS_H), (const pg8::bf16_t*)(ws + WS_WAB) + (size_t)jl * 2816 * 1024, MTOK, 2816, 1024, 1024};
            pg8::StaticOrder S; S.init(MTOK, 2816, F.G, F.bid);
            pg8::EpiProj<0> E{(pg8::bf16_t*)(ws + WS_G), (pg8::bf16_t*)(ws + WS_G + G_VTA), (const float*)(ws + WS_ROPE), (const float*)(ws + WS_ROPE) + 1024, F.out + O_AK, F.out + O_AV, jl};
            pg8::gemm_phase<pg8::EpiProj<0>, pg8::StaticOrder, true, true>(F.lds, g, S, E, F.tid); }
        } else if (kind == 5) {
            if (EN(5)) rwkv_r1(F, jl, 0);
        } else if (kind == 6) { if (EN(6)) rwkv_post_phase(F, jl); }
        else if (kind == 12 || kind == 14) { if (F.wave < 2) { if (EN(13)) rwkv_r2a(F, jl, kind == 14 ? 1 : 0); } if (EN(12) && !rep) attnA_phase(F, jl); }
        else if (kind == 13) { if (EN(5)) rwkv_r1(F, jl, 1); }
        else if (kind == 15) { if (EN(13)) rwkv_r2b(F, jl, dsel); if (EN(12) && !rep) attnA_phase(F, jl); }
        else if (kind == 7 || kind == 10) { if (EN(7)) {
            pg8::Gemm g{(const pg8::bf16_t*)(ws + WS_H), (const pg8::bf16_t*)(ws + (kind == 7 ? WS_WABO : WS_WCO)) + (size_t)jl * 1024 * 1024, MTOK, 1024, 1024, 1024};
            pg8::StaticOrder S; S.init(MTOK, 1024, F.G, F.bid); pg8::EpiResid<false> E{F.out, modp + (size_t)l * 9 * 9216 + 5 * 1024, rscale};
            pg8::gemm_phase<pg8::EpiResid<false>, pg8::StaticOrder, true, true>(F.lds, g, S, E, F.tid); }
        } else if (kind == 8) { if (EN(8)) {
            pg8::Gemm g{(const pg8::bf16_t*)(ws + WS_H), (const pg8::bf16_t*)(ws + WS_WC) + (size_t)jl * 3072 * 1024, MTOK, 3072, 1024, 1024};
            pg8::StaticOrder S; S.init(MTOK, 3072, F.G, F.bid);
            pg8::EpiProj<1> E{(pg8::bf16_t*)(ws + WS_G), (pg8::bf16_t*)(ws + WS_G + G_VTC), (const float*)(ws + WS_ROPE), (const float*)(ws + WS_ROPE) + 1024, F.out + O_CK, F.out + O_CV, jl};
            pg8::gemm_phase<pg8::EpiProj<1>, pg8::StaticOrder, true, true>(F.lds, g, S, E, F.tid); }
        } else if (kind == 9) { if (EN(9)) attnC2_phase(F, jl, l); }
        else { if (EN(11)) final_norm_phase(F); }

    }
}
#ifndef MK_ONE_LAUNCH
#define MK_ONE_LAUNCH 1
#endif
extern "C" void kernel_launch(void* const* d_in, const int* in_sizes, int n_in, void* d_out, int out_size, void* d_ws, size_t ws_size, hipStream_t stream) {
    static int grid = 0;
    if (grid == 0) {
        if (n_in != 38 || (size_t)out_size != O_END || ws_size < WS_END2) { fprintf(stderr, "kernel_launch: unexpected sizes n_in %d out %d ws %zu (need %zu)\n", n_in, out_size, ws_size, (size_t)WS_END2); grid = -1; return; }
        int dev = 0, cus = 0, per = 0;
        (void)hipGetDevice(&dev); (void)hipDeviceGetAttribute(&cus, hipDeviceAttributeMultiprocessorCount, dev);
        (void)hipFuncSetAttribute((const void*)fwd_kernel, hipFuncAttributeMaxDynamicSharedMemorySize, LDS_BYTES);
        (void)hipOccupancyMaxActiveBlocksPerMultiprocessor(&per, (const void*)fwd_kernel, 512, LDS_BYTES);
        if (per < 1) { fprintf(stderr, "kernel_launch: occupancy query says %d blocks per CU\n", per); per = 1; }
        grid = cus;
        (void)hipGetLastError();
    }
    if (grid < 0) return;
    Args a{};
    for (int i = 0; i < 38; ++i) a.in[i] = (const float*)d_in[i];
    a.out = (float*)d_out; a.ws = (unsigned char*)d_ws;
#if MK_ONE_LAUNCH
    (void)hipMemsetAsync(d_ws, 0, 16384, stream);
    a.ph_lo = 0; a.ph_hi = NPHASE;
    void* kargs[] = {&a};
    hipError_t e = hipLaunchCooperativeKernel((const void*)fwd_kernel, dim3(grid), dim3(512), kargs, LDS_BYTES, stream);
    if (e != hipSuccess) fprintf(stderr, "cooperative launch failed: %s\n", hipGetErrorString(e));
#else
    for (int ph = 0; ph < NPHASE; ++ph) { a.ph_lo = ph; a.ph_hi = ph + 1; hipLaunchKernelGGL(fwd_kernel, dim3(grid), dim3(512), LDS_BYTES, stream, a); }
#endif
}
```
